# Optimizing an MI355X kernel written in HIP

```python
import math
import jax
import jax.numpy as jnp
from jax import lax
import numpy as np

D_MODEL = 4096
BATCH = 1
SEQ = 16384
DEPTH = 1

PLE_DIM = 256
D_MIX = D_MODEL
D_ATTN = D_MIX // 2
D_SSM = D_MIX - D_ATTN
HEAD_DIM = 64
N_Q_HEADS = D_ATTN // HEAD_DIM
N_KV_HEADS = N_Q_HEADS // 8
Q_PER_KV = N_Q_HEADS // N_KV_HEADS
WINDOW = 128
ROPE_THETA = 10000.0
SSM_HEAD_DIM = 64
N_SSM_HEADS = D_SSM // SSM_HEAD_DIM
SSM_STATE = 128
SSM_GROUPS = 8
HEADS_PER_GROUP = N_SSM_HEADS // SSM_GROUPS
SSM_CONV = 4
CHUNK = 128
D_FF = ((8 * D_MODEL // 3 + 255) // 256) * 256
FFN_CONV = 3
EPS = 1e-6

Q_COLS = N_Q_HEADS * HEAD_DIM
KV_COLS = N_KV_HEADS * HEAD_DIM
XBC_COLS = D_SSM + 2 * SSM_GROUPS * SSM_STATE
D_IN_PROJ = Q_COLS + 2 * KV_COLS + D_SSM + XBC_COLS + N_SSM_HEADS
SPLITS = [Q_COLS, Q_COLS + KV_COLS, Q_COLS + 2 * KV_COLS, Q_COLS + 2 * KV_COLS + D_SSM,
          Q_COLS + 2 * KV_COLS + D_SSM + XBC_COLS]

kernel_name = 'hymba_swa_sink_ssd_convglu_ple'


def rms_norm(x, g):
    xf = x.astype(jnp.float32)
    y = xf * lax.rsqrt(jnp.mean(xf * xf, axis=-1, keepdims=True) + EPS)
    return (y * g.astype(jnp.float32)).astype(x.dtype)


def causal_dwconv(x, w, b):
    K = w.shape[0]
    S = x.shape[1]
    xp = jnp.pad(x, ((0, 0), (K - 1, 0), (0, 0)))
    w = w.astype(x.dtype)
    y = xp[:, 0:S] * w[0]
    for k in range(1, K):
        y = y + xp[:, k:k + S] * w[k]
    return y + b.astype(x.dtype)


def rope(x, positions):
    half = x.shape[-1] // 2
    inv_freq = ROPE_THETA ** (-jnp.arange(half, dtype=jnp.float32) / half)
    ang = positions.astype(jnp.float32)[..., None] * inv_freq
    cos = jnp.cos(ang)[:, :, None, :]
    sin = jnp.sin(ang)[:, :, None, :]
    xf = x.astype(jnp.float32)
    x1, x2 = xf[..., :half], xf[..., half:]
    return jnp.concatenate([x1 * cos - x2 * sin, x2 * cos + x1 * sin], axis=-1).astype(x.dtype)


def sliding_window_attention(q, k, v, sinks):
    B, S = q.shape[0], q.shape[1]
    nb = S // WINDOW
    qb = q.reshape(B, nb, WINDOW, N_KV_HEADS, Q_PER_KV, HEAD_DIM)

    def band(t):
        tp = jnp.pad(t, ((0, 0), (WINDOW, 0), (0, 0), (0, 0)))
        tp = tp.reshape(B, nb + 1, WINDOW, N_KV_HEADS, HEAD_DIM)
        return jnp.concatenate([tp[:, :-1], tp[:, 1:]], axis=2)

    kb, vb = band(k), band(v)
    scores = jnp.einsum('bnqkgd,bnskd->bnkgqs', qb, kb,
                        preferred_element_type=jnp.float32) * (HEAD_DIM ** -0.5)
    qi = jnp.arange(WINDOW)[:, None]
    si = jnp.arange(2 * WINDOW)[None, :]
    diff = qi + WINDOW - si
    in_band = (diff >= 0) & (diff < WINDOW)
    key_pos = (jnp.arange(nb)[:, None] - 1) * WINDOW + jnp.arange(2 * WINDOW)[None, :]
    valid = in_band[None] & (key_pos >= 0)[:, None, :]
    scores = jnp.where(valid[None, :, None, None], scores, -jnp.inf)
    sink = jnp.broadcast_to(
        sinks.astype(jnp.float32).reshape(1, 1, N_KV_HEADS, Q_PER_KV, 1, 1),
        scores.shape[:-1] + (1,))
    probs = jax.nn.softmax(jnp.concatenate([scores, sink], axis=-1), axis=-1)[..., :-1]
    out = jnp.einsum('bnkgqs,bnskd->bnqkgd', probs.astype(v.dtype), vb)
    return out.reshape(B, S, N_Q_HEADS * HEAD_DIM)


def ssd_mixer(z, xbc, dt, conv_w, conv_b, dt_bias, a_log, d_skip, norm_g):
    B, S = z.shape[0], z.shape[1]
    f32 = jnp.float32
    G, R, P, N, L = SSM_GROUPS, HEADS_PER_GROUP, SSM_HEAD_DIM, SSM_STATE, CHUNK
    nc = S // L
    xbc = jax.nn.silu(causal_dwconv(xbc, conv_w, conv_b)).astype(f32)
    xs = xbc[..., :D_SSM]
    bm = xbc[..., D_SSM:D_SSM + G * N]
    cm = xbc[..., D_SSM + G * N:]
    dt = jax.nn.softplus(dt.astype(f32) + dt_bias.astype(f32))
    a = -jnp.exp(a_log.astype(f32)).reshape(G, R)
    x = xs.reshape(B, nc, L, G, R, P)
    dtc = dt.reshape(B, nc, L, G, R)
    xdt = x * dtc[..., None]
    bmat = bm.reshape(B, nc, L, G, N)
    cmat = cm.reshape(B, nc, L, G, N)
    a_cs = jnp.cumsum(jnp.moveaxis(dtc * a, 2, -1), axis=-1)
    li = jnp.arange(L)
    causal = li[:, None] >= li[None, :]
    seg = a_cs[..., :, None] - a_cs[..., None, :]
    decay = jnp.exp(jnp.where(causal, seg, -jnp.inf))
    cb = jnp.einsum('bclgn,bcsgn->bcgls', cmat, bmat)
    w_intra = cb[:, :, :, None] * decay
    y_diag = jnp.einsum('bcgrls,bcsgrp->bclgrp', w_intra, xdt)
    decay_to_end = jnp.moveaxis(jnp.exp(a_cs[..., -1:] - a_cs), -1, 2)
    chunk_states = jnp.einsum('bclgn,bclgrp->bcgrpn', bmat, xdt * decay_to_end[..., None])
    chunk_decay = jnp.exp(a_cs[..., -1])

    def step(state, inp):
        s_c, d_c = inp
        return state * d_c[..., None, None] + s_c, state

    init = jnp.zeros((B, G, R, P, N), f32)
    _, prev = lax.scan(step, init, (jnp.moveaxis(chunk_states, 1, 0), jnp.moveaxis(chunk_decay, 1, 0)))
    prev = jnp.moveaxis(prev, 0, 1)
    decay_in = jnp.moveaxis(jnp.exp(a_cs), -1, 2)[..., None]
    y_off = jnp.einsum('bclgn,bcgrpn->bclgrp', cmat, prev) * decay_in
    y = y_diag + y_off + x * d_skip.astype(f32).reshape(G, R)[:, :, None]
    y = y.reshape(B, S, D_SSM) * jax.nn.silu(z.astype(f32))
    return rms_norm(y, norm_g).astype(z.dtype)


def conv_glu_ffn(h, w_up, conv_w, conv_b, w_down):
    u = causal_dwconv(h @ w_up, conv_w, conv_b)
    gate, up = u[..., :D_FF], u[..., D_FF:]
    return (jax.nn.silu(gate) * up) @ w_down


def setup_inputs(seed: int = 0) -> dict:
    key = jax.random.key(seed)
    ks = jax.random.split(key, 24)
    f32 = jnp.float32

    def nrm(k, shape, scale):
        return jax.random.normal(k, shape, f32) * scale

    x = nrm(ks[0], (BATCH, SEQ, D_MODEL), 1.0)
    p = nrm(ks[1], (DEPTH, BATCH, SEQ, PLE_DIM), 1.0)
    positions = jnp.broadcast_to(jnp.arange(SEQ, dtype=jnp.int32), (BATCH, SEQ))
    norm_mix_g = 1.0 + nrm(ks[2], (DEPTH, D_MODEL), 0.02)
    w_in = nrm(ks[3], (DEPTH, D_MODEL, D_IN_PROJ), D_MODEL ** -0.5)
    attn_sinks = nrm(ks[4], (DEPTH, N_Q_HEADS), 0.5)
    ssm_conv_w = nrm(ks[5], (DEPTH, SSM_CONV, XBC_COLS), SSM_CONV ** -0.5)
    ssm_conv_b = nrm(ks[6], (DEPTH, XBC_COLS), 0.02)
    dt0 = jnp.exp(jax.random.uniform(ks[7], (DEPTH, N_SSM_HEADS), f32,
                                     math.log(1e-3), math.log(1e-1)))
    ssm_dt_bias = dt0 + jnp.log(-jnp.expm1(-dt0))
    ssm_a_log = jnp.log(jax.random.uniform(ks[8], (DEPTH, N_SSM_HEADS), f32, 1.0, 16.0))
    ssm_d = 1.0 + nrm(ks[9], (DEPTH, N_SSM_HEADS), 0.1)
    ssm_norm_g = 1.0 + nrm(ks[10], (DEPTH, D_SSM), 0.02)
    w_o = nrm(ks[11], (DEPTH, D_MIX, D_MODEL), D_MIX ** -0.5)
    norm_ffn_g = 1.0 + nrm(ks[12], (DEPTH, D_MODEL), 0.02)
    w_up = nrm(ks[13], (DEPTH, D_MODEL, 2 * D_FF), D_MODEL ** -0.5)
    ffn_conv_w = nrm(ks[14], (DEPTH, FFN_CONV, 2 * D_FF), FFN_CONV ** -0.5)
    ffn_conv_b = nrm(ks[15], (DEPTH, 2 * D_FF), 0.02)
    w_down = nrm(ks[16], (DEPTH, D_FF, D_MODEL), D_FF ** -0.5)
    ple_gate_w = nrm(ks[17], (DEPTH, D_MODEL, D_MODEL), D_MODEL ** -0.5)
    ple_gate_b = nrm(ks[18], (DEPTH, D_MODEL), 0.01)
    ple_proj = nrm(ks[19], (DEPTH, PLE_DIM, D_MODEL), PLE_DIM ** -0.5)
    norm_final_g = 1.0 + nrm(ks[20], (D_MODEL,), 0.02)
    return {'x': x, 'p': p, 'positions': positions, 'norm_mix_g': norm_mix_g, 'w_in': w_in,
            'attn_sinks': attn_sinks, 'ssm_conv_w': ssm_conv_w, 'ssm_conv_b': ssm_conv_b,
            'ssm_dt_bias': ssm_dt_bias, 'ssm_a_log': ssm_a_log, 'ssm_d': ssm_d,
            'ssm_norm_g': ssm_norm_g, 'w_o': w_o, 'norm_ffn_g': norm_ffn_g, 'w_up': w_up,
            'ffn_conv_w': ffn_conv_w, 'ffn_conv_b': ffn_conv_b, 'w_down': w_down,
            'ple_gate_w': ple_gate_w, 'ple_gate_b': ple_gate_b, 'ple_proj': ple_proj,
            'norm_final_g': norm_final_g}


def reference(x, p, positions, norm_mix_g, w_in, attn_sinks, ssm_conv_w, ssm_conv_b,
              ssm_dt_bias, ssm_a_log, ssm_d, ssm_norm_g, w_o, norm_ffn_g, w_up,
              ffn_conv_w, ffn_conv_b, w_down, ple_gate_w, ple_gate_b, ple_proj,
              norm_final_g):
    B, S = x.shape[0], x.shape[1]
    h = x
    for i in range(DEPTH):
        hn = rms_norm(h, norm_mix_g[i])
        proj = hn @ w_in[i]
        q, k, v, z, xbc, dt = jnp.split(proj, SPLITS, axis=-1)
        q = rope(q.reshape(B, S, N_Q_HEADS, HEAD_DIM), positions)
        k = rope(k.reshape(B, S, N_KV_HEADS, HEAD_DIM), positions)
        v = v.reshape(B, S, N_KV_HEADS, HEAD_DIM)
        y_attn = sliding_window_attention(q, k, v, attn_sinks[i])
        y_ssm = ssd_mixer(z, xbc, dt, ssm_conv_w[i], ssm_conv_b[i], ssm_dt_bias[i],
                          ssm_a_log[i], ssm_d[i], ssm_norm_g[i])
        h = h + jnp.concatenate([y_attn, y_ssm], axis=-1) @ w_o[i]
        h = h + conv_glu_ffn(rms_norm(h, norm_ffn_g[i]), w_up[i], ffn_conv_w[i],
                             ffn_conv_b[i], w_down[i])
        gate = jax.nn.sigmoid((h @ ple_gate_w[i] + ple_gate_b[i]).astype(jnp.float32)).astype(h.dtype)
        h = h + gate * (p[i] @ ple_proj[i])
    return rms_norm(h, norm_final_g)
```

```cpp
#include <hip/hip_runtime.h>
#include <cstdio>
#include <cstdint>
#include <cstring>
namespace pg8 {
#define PG8_LAS __attribute__((address_space(3)))
typedef unsigned short bf16_t;
typedef short bf16x8 __attribute__((ext_vector_type(8)));
typedef float f32x4 __attribute__((ext_vector_type(4)));
typedef unsigned u32x4 __attribute__((ext_vector_type(4)));
typedef int i32x4 __attribute__((ext_vector_type(4)));
constexpr int BM = 256, BK = 64, HALF = 128, HTB = HALF * BK * 2  , STAGE_BYTES = 8 * HTB, NXCD = 8, WGM = 8;

__host__ __device__ __forceinline__ int lds_byte(int r, int c) { const int st = (r >> 4) * 2 + (c >> 5), rr = r & 15, cc = c & 31, ob = rr * 64 + cc * 2; return st * 1024 + (ob ^ (((ob >> 9) & 1) << 5)); }
__host__ __device__ __forceinline__ void stage_rc(int b, int& R, int& C) { const int st = b / 1024, sb = b % 1024, swz = sb ^ (((sb >> 9) & 1) << 5); R = (st >> 1) * 16 + swz / 64; C = (st & 1) * 32 + (swz % 64) / 2; }
__host__ __device__ __forceinline__ int perm32(int rho) { const int n = rho >> 4, i = rho & 15; return 8 * (i >> 2) + 4 * n + (i & 3); }

struct Unit { int pm, pn; };
struct Gemm { const bf16_t* A; const bf16_t* Bt; int M, N, K; size_t a_tstep = 0; };

struct StaticOrder {
    int nM, nN, nwg, G, c;
    __host__ __device__ void init(int M, int N, int G_, int c_) { nM = M / BM; nN = N / BM; nwg = nM * nN; G = G_; c = c_; }
    __host__ __device__ bool next(int i, Unit& u) const {
        const long L = (long)i * G + c; if (L >= nwg) return false;
        int wgid = (int)L; { const int q = nwg / NXCD, r = nwg % NXCD, xcd = wgid % NXCD, off = wgid / NXCD; wgid = (xcd < r ? xcd * (q + 1) : r * (q + 1) + (xcd - r) * q) + off; }
        const int nig = WGM * nN, gid = wgid / nig, fm = gid * WGM, gsz = (nM - fm) < WGM ? (nM - fm) : WGM;
        u.pm = fm + ((wgid % nig) % gsz); u.pn = (wgid % nig) / gsz; return true;
    }
    __device__ __forceinline__ void a_ready(const Unit&) const {}
    __device__ __forceinline__ void done(const Unit&) const {}
};
__device__ __forceinline__ unsigned cvt_pk_bf16(float lo, float hi) { unsigned r; asm volatile("v_cvt_pk_bf16_f32 %0, %1, %2" : "=v"(r) : "v"(lo), "v"(hi)); return r; }
template <class Epi, class Sched, bool ALIGN_EPI = false, bool SP2 = false>
__device__ __forceinline__ void gemm_phase(PG8_LAS unsigned char* lds, const Gemm g, const Sched& S, const Epi& E) {
    const int tid = threadIdx.x, wid = __builtin_amdgcn_readfirstlane(tid >> 6), lane = tid & 63, wr = wid >> 2, wc = wid & 3, fr = lane & 15, fq = lane >> 4;
    const int K = g.K, nt = Epi::I8 ? K / 128 : K / BK;
    unsigned voffA[2], voffB[2];
#pragma unroll
    for (int i = 0; i < 2; ++i) { int R, C; stage_rc(tid * 16 + i * 8192, R, C); const int Rb = Epi::PERM ? ((R & ~31) + perm32(R & 31)) : R;
        const int Ra = Epi::APERM ? ((R & ~63) | (4 * (R & 15) + ((R >> 4) & 3))) : R;
        voffA[i] = Epi::I8 ? (unsigned)(Ra * K + 2 * C) : (unsigned)(Ra * K + C) * 2u; voffB[i] = Epi::I8 ? (unsigned)(Rb * K + 2 * C) : (unsigned)(Rb * K + C) * 2u; }
    const size_t kstep = (size_t)(BK * 2);
    const size_t hstep = (size_t)HALF * K * (Epi::I8 ? 1 : 2);
    const size_t tstep = 2 * hstep;
    const size_t tstepA = g.a_tstep ? g.a_tstep : tstep;
    const unsigned ldsw = (unsigned)wid * 1024u;
    const int aoff = lds_byte(wr * 64 + fr, fq * 8), boff = lds_byte(wc * 32 + fr, fq * 8);
#define PG8_SA(b, h) (((b) * 2 + (h)) * HTB)
#define PG8_SB(b, h) ((4 + (b) * 2 + (h)) * HTB)
#define PG8_STAGE(bufoff, gbase, voff) do { _Pragma("unroll") for (int _i = 0; _i < 2; ++_i) \
        __builtin_amdgcn_global_load_lds((const unsigned*)((const char*)(gbase) + (voff)[_i]), (PG8_LAS unsigned*)(lds + (bufoff) + ldsw + _i * 8192), 16, 0, 0); } while (0)
#define PG8_LDA(dst, b, h) do { _Pragma("unroll") for (int m = 0; m < 4; ++m) _Pragma("unroll") for (int k = 0; k < 2; ++k) dst[m][k] = *(const PG8_LAS bf16x8*)(lds + PG8_SA(b, h) + aoff + m * 2048 + k * 1024); } while (0)
#define PG8_LDB(dst, b, h) do { _Pragma("unroll") for (int n = 0; n < 2; ++n) _Pragma("unroll") for (int k = 0; k < 2; ++k) dst[n][k] = *(const PG8_LAS bf16x8*)(lds + PG8_SB(b, h) + boff + n * 2048 + k * 1024); } while (0)
#define PG8_MMA(ai, bj, At, Bt) do { __builtin_amdgcn_s_setprio(1); _Pragma("unroll") for (int m = 0; m < 4; ++m) _Pragma("unroll") for (int n = 0; n < 2; ++n) _Pragma("unroll") for (int k = 0; k < 2; ++k) \
        { if constexpr (Epi::I8) acc[ai][bj][m][n] = __builtin_bit_cast(f32x4, __builtin_amdgcn_mfma_i32_16x16x64_i8(__builtin_bit_cast(i32x4, Bt[n][k]), __builtin_bit_cast(i32x4, At[m][k]), __builtin_bit_cast(i32x4, acc[ai][bj][m][n]), 0, 0, 0)); \
          else acc[ai][bj][m][n] = __builtin_amdgcn_mfma_f32_16x16x32_bf16(Bt[n][k], At[m][k], acc[ai][bj][m][n], 0, 0, 0); } __builtin_amdgcn_s_setprio(0); } while (0)
#define PG8_WAIT_V(n) asm volatile("s_waitcnt vmcnt(" #n ")" ::: "memory")
#define PG8_WAIT_L(n) asm volatile("s_waitcnt lgkmcnt(" #n ")" ::: "memory")
#define PG8_BAR __builtin_amdgcn_s_barrier()
#define PG8_SCHED __builtin_amdgcn_sched_barrier(0)
    Unit cur, nxt; int ui = 0;
    if (!S.next(0, cur)) return;
    f32x4 acc[2][2][4][2];
#pragma unroll
    for (int a = 0; a < 2; ++a)
#pragma unroll
        for (int b = 0; b < 2; ++b)
#pragma unroll
            for (int m = 0; m < 4; ++m)
#pragma unroll
                for (int n = 0; n < 2; ++n) acc[a][b][m][n] = (f32x4){0.f, 0.f, 0.f, 0.f};
    bf16x8 At[4][2], B0[2][2], B1[2][2];
    const char* cA = (const char*)g.A + (size_t)cur.pm * tstepA; const char* cB = (const char*)g.Bt + (size_t)cur.pn * tstep;
    S.a_ready(cur);
    if constexpr (SP2) {
        PG8_STAGE(PG8_SB(0, 0), cB, voffB); PG8_STAGE(PG8_SB(0, 1), cB + hstep, voffB); PG8_STAGE(PG8_SA(0, 0), cA, voffA); PG8_STAGE(PG8_SA(0, 1), cA + hstep, voffA);
        if (wr == 1) PG8_BAR;
        PG8_WAIT_V(2); PG8_BAR;
        PG8_STAGE(PG8_SB(1, 0), cB + kstep, voffB); PG8_STAGE(PG8_SA(1, 0), cA + kstep, voffA); PG8_STAGE(PG8_SB(1, 1), cB + hstep + kstep, voffB);
        PG8_WAIT_V(6); PG8_BAR;
    } else {
        PG8_STAGE(PG8_SB(0, 0), cB, voffB); PG8_STAGE(PG8_SA(0, 0), cA, voffA); PG8_STAGE(PG8_SB(0, 1), cB + hstep, voffB); PG8_STAGE(PG8_SA(0, 1), cA + hstep, voffA);
        if (wr == 1) PG8_BAR;
        PG8_WAIT_V(4); PG8_BAR;
        PG8_STAGE(PG8_SB(1, 0), cB + kstep, voffB); PG8_STAGE(PG8_SA(1, 0), cA + kstep, voffA); PG8_STAGE(PG8_SB(1, 1), cB + hstep + kstep, voffB);
        PG8_WAIT_V(6); PG8_BAR;
    }
    for (;;) {
        const bool has_next = S.next(ui + 1, nxt);
        const char* nA = has_next ? (const char*)g.A + (size_t)nxt.pm * tstepA : cA; const char* nB = has_next ? (const char*)g.Bt + (size_t)nxt.pn * tstep : cB;
        for (int t = 0; t < nt; t += 2) {
            const bool last = (t == nt - 2);
            const char* a1 = cA + (size_t)(t + 1) * kstep;
            const char* a2 = last ? nA : cA + (size_t)(t + 2) * kstep; const char* b2 = last ? nB : cB + (size_t)(t + 2) * kstep;
            const char* a3 = a2 + kstep; const char* b3 = b2 + kstep;
            if (last && has_next) S.a_ready(nxt);
            if constexpr (Epi::HAS_MID) { if (t == E.tmid) E.mid(acc, cur, wr, fr); }
            if constexpr (SP2) {
            PG8_LDB(B0, 0, 0); PG8_LDB(B1, 0, 1); PG8_SCHED; PG8_LDA(At, 0, 0); PG8_STAGE(PG8_SA(1, 1), a1 + hstep, voffA);
            PG8_WAIT_V(8); PG8_WAIT_L(0); PG8_BAR; PG8_MMA(0, 0, At, B0); PG8_MMA(0, 1, At, B1); PG8_BAR; PG8_SCHED;
            PG8_LDA(At, 0, 1); PG8_STAGE(PG8_SB(0, 0), b2, voffB); PG8_STAGE(PG8_SB(0, 1), b2 + hstep, voffB); PG8_STAGE(PG8_SA(0, 0), a2, voffA);
            PG8_WAIT_V(8); PG8_WAIT_L(0); PG8_BAR; PG8_MMA(1, 0, At, B0); PG8_MMA(1, 1, At, B1); PG8_BAR; PG8_SCHED;
            PG8_LDB(B0, 1, 0); PG8_LDB(B1, 1, 1); PG8_SCHED; PG8_LDA(At, 1, 0); PG8_STAGE(PG8_SA(0, 1), a2 + hstep, voffA);
            PG8_WAIT_V(8); PG8_WAIT_L(0); PG8_BAR; PG8_MMA(0, 0, At, B0); PG8_MMA(0, 1, At, B1); PG8_BAR; PG8_SCHED;
            PG8_LDA(At, 1, 1); PG8_STAGE(PG8_SB(1, 0), b3, voffB); PG8_STAGE(PG8_SB(1, 1), b3 + hstep, voffB); PG8_STAGE(PG8_SA(1, 0), a3, voffA);
            PG8_WAIT_V(8); PG8_WAIT_L(0); PG8_BAR; PG8_MMA(1, 0, At, B0); PG8_MMA(1, 1, At, B1); PG8_BAR; PG8_SCHED;
            } else {
            PG8_LDB(B0, 0, 0); PG8_SCHED; PG8_LDA(At, 0, 0); PG8_STAGE(PG8_SA(1, 1), a1 + hstep, voffA);
            PG8_WAIT_L(8); PG8_BAR; PG8_WAIT_L(0); PG8_MMA(0, 0, At, B0); PG8_BAR; PG8_SCHED;
            PG8_LDB(B1, 0, 1); PG8_STAGE(PG8_SB(0, 0), b2, voffB);
            PG8_BAR; PG8_WAIT_L(0); PG8_MMA(0, 1, At, B1); PG8_BAR;
            PG8_LDA(At, 0, 1); PG8_STAGE(PG8_SA(0, 0), a2, voffA);
            PG8_BAR; PG8_WAIT_L(0); PG8_MMA(1, 0, At, B0); PG8_BAR; PG8_SCHED;
            PG8_STAGE(PG8_SB(0, 1), b2 + hstep, voffB);
            PG8_WAIT_V(6); PG8_BAR; PG8_MMA(1, 1, At, B1); PG8_BAR;
            PG8_LDB(B0, 1, 0); PG8_SCHED; PG8_LDA(At, 1, 0); PG8_STAGE(PG8_SA(0, 1), a2 + hstep, voffA);
            PG8_WAIT_L(8); PG8_BAR; PG8_WAIT_L(0); PG8_MMA(0, 0, At, B0); PG8_BAR; PG8_SCHED;
            PG8_LDB(B1, 1, 1); PG8_STAGE(PG8_SB(1, 0), b3, voffB);
            PG8_BAR; PG8_WAIT_L(0); PG8_MMA(0, 1, At, B1); PG8_BAR;
            PG8_LDA(At, 1, 1); PG8_STAGE(PG8_SA(1, 0), a3, voffA);
            PG8_BAR; PG8_WAIT_L(0); PG8_MMA(1, 0, At, B0); PG8_BAR; PG8_SCHED;
            PG8_STAGE(PG8_SB(1, 1), b3 + hstep, voffB);
            PG8_WAIT_V(6); PG8_BAR; PG8_MMA(1, 1, At, B1); PG8_BAR;
            }
        }
        if constexpr (ALIGN_EPI) { if (wr == 0) PG8_BAR; }
        if constexpr (!Epi::AFTER_DRAIN) { E(acc, cur, wr, wc, fr, fq); S.done(cur); }
        if (!has_next) break;
#pragma unroll
        for (int a = 0; a < 2; ++a)
#pragma unroll
            for (int b = 0; b < 2; ++b)
#pragma unroll
                for (int m = 0; m < 4; ++m)
#pragma unroll
                    for (int n = 0; n < 2; ++n) acc[a][b][m][n] = (f32x4){0.f, 0.f, 0.f, 0.f};
        cur = nxt; cA = nA; cB = nB; ++ui;
        if constexpr (ALIGN_EPI) { if (wr == 1) PG8_BAR; }
    }
    PG8_WAIT_V(0);
    if constexpr (!ALIGN_EPI) { if (wr == 0) PG8_BAR; }
    PG8_BAR;
    if constexpr (Epi::AFTER_DRAIN) { E.fused(acc, cur, wr, wc, fr, fq, lds, wid, lane); S.done(cur); }
#undef PG8_SA
#undef PG8_SB
#undef PG8_STAGE
#undef PG8_LDA
#undef PG8_LDB
#undef PG8_MMA
#undef PG8_WAIT_V
#undef PG8_WAIT_L
#undef PG8_BAR
#undef PG8_SCHED
}
}

constexpr int SEQ = 16384, DM = 4096;
constexpr int NQH = 32, NKVH = 4, HD = 64;
constexpr int DSSM = 2048, NSH = 32, SSTATE = 128, SGRP = 8;
constexpr int XBCC = 4096, NPROJ = 8736, NPROJ_PAD = 8960;
constexpr int DFF = 11008, PLE = 256;
constexpr float EPS = 1e-6f;

typedef unsigned short bf16_t;
using pg8::f32x4; using pg8::u32x4; using pg8::cvt_pk_bf16;
typedef unsigned u32x2 __attribute__((ext_vector_type(2)));
#define LAS __attribute__((address_space(3)))

__device__ __forceinline__ float bf2f(unsigned b) { return __uint_as_float(b << 16); }
__device__ __forceinline__ u32x4 pack8(const f32x4 a, const f32x4 b) { u32x4 w; w.x = cvt_pk_bf16(a[0], a[1]); w.y = cvt_pk_bf16(a[2], a[3]); w.z = cvt_pk_bf16(b[0], b[1]); w.w = cvt_pk_bf16(b[2], b[3]); return w; }
__device__ __forceinline__ u32x2 pack4(const f32x4 a) { u32x2 w; w.x = cvt_pk_bf16(a[0], a[1]); w.y = cvt_pk_bf16(a[2], a[3]); return w; }
__device__ __forceinline__ void unpack8(const u32x4 w, float (&o)[8]) {
    o[0] = bf2f(w.x & 0xffffu); o[1] = __uint_as_float(w.x & 0xffff0000u); o[2] = bf2f(w.y & 0xffffu); o[3] = __uint_as_float(w.y & 0xffff0000u);
    o[4] = bf2f(w.z & 0xffffu); o[5] = __uint_as_float(w.z & 0xffff0000u); o[6] = bf2f(w.w & 0xffffu); o[7] = __uint_as_float(w.w & 0xffff0000u); }
__device__ __forceinline__ float silu_f(float x) { return x * __builtin_amdgcn_rcpf(1.f + __expf(-x)); }
__device__ __forceinline__ float sigm_f(float x) { return __builtin_amdgcn_rcpf(1.f + __expf(-x)); }
__device__ __forceinline__ float softplus_f(float x) { return x > 20.f ? x : log1pf(expf(x)); }
__device__ __forceinline__ float wave_sum(float v) {
#pragma unroll
    for (int o = 1; o < 64; o <<= 1) v += __shfl_xor(v, o);
    return v;
}

constexpr size_t MiB = 1u << 20;
constexpr size_t WS_CTL = 0, CTL_ZERO_BYTES = 1 * MiB;
constexpr size_t WS_RS0 = 1 * MiB;
constexpr size_t WS_COS = 2 * MiB, WS_SIN = 4 * MiB;
constexpr size_t WS_DT = 6 * MiB;
constexpr size_t WS_WIN = 8 * MiB;
constexpr size_t WS_WO = 78 * MiB;
constexpr size_t WS_WUP = 110 * MiB;
constexpr size_t WS_WDN = 282 * MiB;
constexpr size_t WS_WG = 368 * MiB;
constexpr size_t WS_WP = 400 * MiB;
constexpr size_t WS_PB = 402 * MiB;
constexpr size_t WS_XB = 410 * MiB;
constexpr size_t WS_MIX = 538 * MiB;
constexpr size_t WS_Y = 666 * MiB;
constexpr size_t WS_PP = 1226 * MiB;
constexpr size_t WS_U = 538 * MiB;
constexpr size_t WS_Q = 794 * MiB;
constexpr size_t WS_K = 858 * MiB;
constexpr size_t WS_V = 866 * MiB;
constexpr size_t WS_Z = 874 * MiB;
constexpr size_t WS_XBC = 938 * MiB;
constexpr size_t WS_XACT = 1066 * MiB;
constexpr size_t WS_ACT = 882 * MiB;
constexpr size_t WS_H1Q = WS_Y, WS_H2Q = WS_MIX;
constexpr size_t WS_END = 1354 * MiB;
constexpr int CW_BAR = 4096;
constexpr int CW_CMAX_UP = 131072, CW_CMAX_G = 131072 + 22016;
constexpr float QCLIP = 4.5f;
constexpr int CW_RSS_SSM = 65536, CW_RSS1 = 65536 + 16384, CW_RSS3 = 65536 + 32768;

#define XB_TMO      128
#define XB_XCNT(j)  (256  + 64 * (j))
#define XB_XSUB(j)  (1280 + 64 * (j))
#define XB_XGEN(j)  (2304 + 64 * (j))
#define XB_TOP      3328
#define XB_TOPGEN   3392
#define XCD_BAR_WORDS 3456
#define XB_SPIN_CAP (1u << 18)

__device__ __forceinline__ unsigned xb_ld(unsigned* p)              { return __hip_atomic_load(p, __ATOMIC_RELAXED, __HIP_MEMORY_SCOPE_AGENT); }
__device__ __forceinline__ unsigned xb_add(unsigned* p, unsigned v) { return __hip_atomic_fetch_add(p, v, __ATOMIC_RELAXED, __HIP_MEMORY_SCOPE_AGENT); }
__device__ __forceinline__ unsigned xb_xcc_id() { return (unsigned)__builtin_amdgcn_s_getreg((3 << 11) | 20) & 0xFu; }
#define XB_SPIN(cond, bar) do { unsigned _sp = 0; while (cond) { __builtin_amdgcn_s_sleep(1); \
    if ((++_sp & 255u) == 0u) { if (xb_ld(&(bar)[XB_TMO])) break; if (_sp > XB_SPIN_CAP) { atomicAdd(&(bar)[XB_TMO], 1u); break; } } } } while (0)

struct XcdBarrier {
    unsigned* bar; unsigned x;
    volatile LAS unsigned* st;
};

__device__ __forceinline__ XcdBarrier xcd_barrier_post(unsigned* bar, volatile LAS unsigned* st) {
    XcdBarrier b; b.bar = bar; b.x = xb_xcc_id(); b.st = st;
    if (threadIdx.x == 0) (void)xb_add(&bar[XB_XCNT(b.x)], 1u);
    return b;
}
__device__ __forceinline__ void xcd_barrier_complete(unsigned* bar, unsigned x, unsigned& nloc, unsigned& nx) {
    const unsigned G = gridDim.x * gridDim.y * gridDim.z;
    unsigned sum, cnt, mine, sp = 0u;
    for (;;) {
        sum = 0u; cnt = 0u; mine = 0u;
#pragma unroll
        for (unsigned j = 0; j < 16; ++j) { const unsigned c = xb_ld(&bar[XB_XCNT(j)]); sum += c; cnt += (c > 0u) ? 1u : 0u; mine = (j == x) ? c : mine; }
        if (sum == G) break;
        __builtin_amdgcn_s_sleep(1);
        if ((++sp & 255u) == 0u) { if (xb_ld(&bar[XB_TMO])) break; if (sp > XB_SPIN_CAP) { atomicAdd(&bar[XB_TMO], 1u); break; } }
    }
    nloc = mine > 0u ? mine : 1u; nx = cnt > 0u ? cnt : 1u;
}

__device__ __forceinline__ void xcd_barrier(const XcdBarrier& b) {
    asm volatile("s_waitcnt vmcnt(0)" ::: "memory");
    __syncthreads();
    if (threadIdx.x == 0) {
        unsigned* bar = b.bar;
        __builtin_amdgcn_s_waitcnt(0);
        unsigned nloc = b.st[0], nx = b.st[1];
        if (nloc == 0u) { xcd_barrier_complete(bar, b.x, nloc, nx); b.st[0] = nloc; b.st[1] = nx; }
        const unsigned old = xb_add(&bar[XB_XSUB(b.x)], 1u);
        const unsigned gen = old / nloc;
        if (old + 1u == (gen + 1u) * nloc) {
            __builtin_amdgcn_fence(__ATOMIC_RELEASE, "agent");
            asm volatile("s_waitcnt vmcnt(0)" ::: "memory");
            const unsigned og = xb_add(&bar[XB_TOP], 1u);
            const unsigned tg = og / nx;
            if (og + 1u == (tg + 1u) * nx) xb_add(&bar[XB_TOPGEN], 1u);
            else XB_SPIN(xb_ld(&bar[XB_TOPGEN]) == tg, bar);
            __builtin_amdgcn_fence(__ATOMIC_ACQUIRE, "agent");
            xb_add(&bar[XB_XGEN(b.x)], 1u);
            asm volatile("s_waitcnt vmcnt(0)" ::: "memory");
        } else {
            XB_SPIN(xb_ld(&bar[XB_XGEN(b.x)]) == gen, bar);
            __builtin_amdgcn_fence(__ATOMIC_ACQUIRE, "agent");
            asm volatile("s_waitcnt vmcnt(0)" ::: "memory");
        }
    }
    __syncthreads();
}
__device__ __forceinline__ int cperm(int p) { return (p & 0xE0) | (((p >> 2) & 3) << 3) | (((p >> 4) & 1) << 2) | (p & 3); }
__device__ __forceinline__ int colmap(int kind, int row) {
    const int tile = row >> 8, p = row & 255;
    if (kind == 0) return (tile << 8) | cperm(p);
    if (kind == 1) {
        if (tile < 9) { const int bj = p >> 7, wc = (p >> 5) & 3, n = (p >> 4) & 1, fq = (p >> 2) & 3, j = p & 3;
            return tile * 256 + (2 * bj + (wc >> 1)) * 64 + 32 * n + 16 * (wc & 1) + 4 * fq + j; }
        if (tile < 34) return (tile << 8) | cperm(p);
        const int c = cperm(p); return c < 32 ? 8704 + c : -1;
    }
    { const int bj = p >> 7, cc = cperm(p) & 127; return bj * DFF + tile * 128 + cc; }
}
__device__ __forceinline__ int srcbase_of(int kind, int r0) {
    if (kind == 2) { const int pn = r0 >> 8, q64 = (r0 >> 6) & 3; return (q64 >> 1) * DFF + pn * 128 + (q64 & 1) * 64; }
    return r0;
}
struct TrJob { const float* W; bf16_t* WT; const float* kscale; const float* qmax; int K, N, nrows, kind, kxor, kscale_n, pad; };
__device__ __forceinline__ void ph_transpose(const TrJob job, LAS unsigned* scr, int gw, int NGW, int lane) {
    const float* __restrict__ W = job.W; bf16_t* __restrict__ WT = job.WT; const float* __restrict__ ks = job.kscale;
    const int ngrp = job.nrows / 64, nitems = (job.K / 64) * ngrp;
    for (int item = gw; item < nitems; item += NGW) {
        const int kb = item / ngrp, gq = item % ngrp, k0 = 64 * kb, r0 = 64 * gq, sb = srcbase_of(job.kind, r0);
        const int n4 = (lane & 15) * 4; const bool inb = sb + n4 < job.N;
        f32x4 v[8][2];
#pragma unroll
        for (int i = 0; i < 8; ++i) { const int kp = 4 * i + (lane >> 4);
#pragma unroll
            for (int q = 0; q < 2; ++q) { const int k = k0 + 2 * kp + q; f32x4 t = {0.f, 0.f, 0.f, 0.f};
                if (inb) t = *(const f32x4*)(W + (size_t)(k ^ job.kxor) * job.N + sb + n4);
                v[i][q] = t; } }
        asm volatile("" ::: "memory");
        if (ks) { float kv[8][2];
#pragma unroll
            for (int i = 0; i < 8; ++i) { const int kp = 4 * i + (lane >> 4);
#pragma unroll
                for (int q = 0; q < 2; ++q) { const int k = k0 + 2 * kp + q; kv[i][q] = k < job.kscale_n ? ks[k] : 1.f; } }
#pragma unroll
            for (int i = 0; i < 8; ++i)
#pragma unroll
                for (int q = 0; q < 2; ++q) v[i][q] = v[i][q] * kv[i][q]; }
#pragma unroll
        for (int i = 0; i < 8; ++i) { const int kp = 4 * i + (lane >> 4);
#pragma unroll
            for (int e = 0; e < 4; ++e) scr[kp * 65 + n4 + e] = cvt_pk_bf16(v[i][0][e], v[i][1][e]); }
        asm volatile("s_waitcnt lgkmcnt(0)" ::: "memory");
        const int c = lane & 7;
#pragma unroll
        for (int j = 0; j < 8; ++j) { const int n = (lane >> 3) + 8 * j; const int sc = colmap(job.kind, r0 + n) - sb;
            u32x4 o = {0u, 0u, 0u, 0u};
            if (sc >= 0) { o.x = scr[(4 * c + 0) * 65 + sc]; o.y = scr[(4 * c + 1) * 65 + sc]; o.z = scr[(4 * c + 2) * 65 + sc]; o.w = scr[(4 * c + 3) * 65 + sc]; }
            *(u32x4*)(WT + (size_t)(r0 + n) * job.K + k0 + 8 * c) = o; }
        asm volatile("s_waitcnt lgkmcnt(0)" ::: "memory");
    }
}
__device__ __forceinline__ void ph_xprep(const float* __restrict__ x, bf16_t* __restrict__ xb, float* __restrict__ rs0, int gw, int NGW, int lane) {
    for (int t = gw; t < SEQ; t += NGW) {
        const f32x4* xr = (const f32x4*)(x + (size_t)t * DM); f32x4 a[8], b[8]; float ss = 0.f;
#pragma unroll
        for (int i = 0; i < 8; ++i) { a[i] = xr[(i * 64 + lane) * 2]; b[i] = xr[(i * 64 + lane) * 2 + 1]; }
#pragma unroll
        for (int i = 0; i < 8; ++i) { ss += (a[i][0] * a[i][0] + a[i][1] * a[i][1]) + (a[i][2] * a[i][2] + a[i][3] * a[i][3]) + (b[i][0] * b[i][0] + b[i][1] * b[i][1]) + (b[i][2] * b[i][2] + b[i][3] * b[i][3]);
            *(u32x4*)(xb + (size_t)t * DM + (i * 64 + lane) * 8) = pack8(a[i], b[i]); }
        ss = wave_sum(ss);
        if (lane == 0) rs0[t] = rsqrtf(ss * (1.f / DM) + EPS);
    }
}
__device__ __forceinline__ void ph_pprep(const float* __restrict__ p, bf16_t* __restrict__ pb, size_t gt, size_t NGT) {
    const size_t n8 = (size_t)SEQ * PLE / 8;
    for (size_t i = gt; i < n8; i += NGT) {
        const f32x4 a = ((const f32x4*)p)[2 * i], b = ((const f32x4*)p)[2 * i + 1]; ((u32x4*)pb)[i] = pack8(a, b); }
}
__device__ __forceinline__ void ph_trig(const int* __restrict__ positions, float* __restrict__ cosT, float* __restrict__ sinT, size_t gt, size_t NGT) {
  for (size_t ii = gt; ii < (size_t)SEQ * 32; ii += NGT) { const int i = (int)ii;
    const int t = i >> 5, f = i & 31;
    const float invf = powf(10000.f, -(float)f / 32.f);
    const float ang = (float)positions[t] * invf;
    float s, c; sincosf(ang, &s, &c); cosT[i] = c; sinT[i] = s; }
}
__device__ __forceinline__ void ph_convglu(const bf16_t* __restrict__ U, const float* __restrict__ cw, const float* __restrict__ cb, bf16_t* __restrict__ ACT, int half, size_t gt, size_t NGT) {
    const size_t nitems = (size_t)688 * (SEQ / 16);
    for (size_t it = gt; it < nitems; it += NGT) {
        const int cgi = (int)(it % 688), seg = (int)(it / 688), pl = cgi >> 4, cc = (cgi & 15) * 8, c0 = (half * 43 + pl) * 128 + cc, t0 = seg * 16;
        float wg[3][8], wu[3][8], bg[8], bu[8];
#pragma unroll
        for (int k = 0; k < 3; ++k) { const f32x4 g0 = *(const f32x4*)(cw + (size_t)k * 2 * DFF + c0), g1 = *(const f32x4*)(cw + (size_t)k * 2 * DFF + c0 + 4), u0 = *(const f32x4*)(cw + (size_t)k * 2 * DFF + DFF + c0), u1 = *(const f32x4*)(cw + (size_t)k * 2 * DFF + DFF + c0 + 4);
#pragma unroll
            for (int e = 0; e < 4; ++e) { wg[k][e] = g0[e]; wg[k][4 + e] = g1[e]; wu[k][e] = u0[e]; wu[k][4 + e] = u1[e]; } }
        { const f32x4 g0 = *(const f32x4*)(cb + c0), g1 = *(const f32x4*)(cb + c0 + 4), u0 = *(const f32x4*)(cb + DFF + c0), u1 = *(const f32x4*)(cb + DFF + c0 + 4);
#pragma unroll
          for (int e = 0; e < 4; ++e) { bg[e] = g0[e]; bg[4 + e] = g1[e]; bu[e] = u0[e]; bu[4 + e] = u1[e]; } }
        u32x4 rg[18], ru[18];
#pragma unroll
        for (int i = 0; i < 18; ++i) { const int tt = t0 - 2 + i;
            if (tt >= 0) { rg[i] = *(const u32x4*)(U + (size_t)tt * DFF + pl * 256 + cc); ru[i] = *(const u32x4*)(U + (size_t)tt * DFF + pl * 256 + 128 + cc); }
            else { rg[i] = (u32x4){0u, 0u, 0u, 0u}; ru[i] = (u32x4){0u, 0u, 0u, 0u}; } }
        float g2[8], g1v[8], u2[8], u1v[8];
        unpack8(rg[0], g2); unpack8(rg[1], g1v); unpack8(ru[0], u2); unpack8(ru[1], u1v);
#pragma unroll
        for (int i = 0; i < 16; ++i) { float gv[8], uv[8]; unpack8(rg[i + 2], gv); unpack8(ru[i + 2], uv); float o[8];
#pragma unroll
            for (int e = 0; e < 8; ++e) { const float g = bg[e] + wg[0][e] * g2[e] + wg[1][e] * g1v[e] + wg[2][e] * gv[e], u = bu[e] + wu[0][e] * u2[e] + wu[1][e] * u1v[e] + wu[2][e] * uv[e];
                o[e] = silu_f(g) * u; g2[e] = g1v[e]; g1v[e] = gv[e]; u2[e] = u1v[e]; u1v[e] = uv[e]; }
            u32x4 w; w.x = cvt_pk_bf16(o[0], o[1]); w.y = cvt_pk_bf16(o[2], o[3]); w.z = cvt_pk_bf16(o[4], o[5]); w.w = cvt_pk_bf16(o[6], o[7]);
            *(u32x4*)(ACT + (size_t)(t0 + i) * DFF + c0) = w; }
    }
}
__device__ __forceinline__ void ph_final_norm(float* H, const float* __restrict__ rowss, const float* __restrict__ g, size_t gt, size_t NGT) {
    const size_t n4 = (size_t)SEQ * DM / 4;
    f32x4* h4 = (f32x4*)H;
    for (size_t i0 = gt; i0 < n4; i0 += 8 * NGT) {
        f32x4 v[8]; float rs[8];
#pragma unroll
        for (int k = 0; k < 8; ++k) { const size_t i = i0 + k * NGT; v[k] = h4[i]; rs[k] = rowss[i >> 10]; }
#pragma unroll
        for (int k = 0; k < 8; ++k) { const size_t i = i0 + k * NGT; const f32x4 gg = ((const f32x4*)g)[i & 1023]; h4[i] = v[k] * rsqrtf(rs[k] * (1.f / DM) + EPS) * gg; }
    }
}

constexpr float CMAX_SAFE = 1.1f;
__device__ __forceinline__ void ph_colmax(const float* __restrict__ W, const float* __restrict__ g, int K, int N, unsigned* cmax, int gw, int NGW, int lane) {
    const int ncb = N / 256, nitems = (K / 64) * ncb;
    for (int item = gw; item < nitems; item += NGW) { const int kb = item / ncb, cb = item % ncb, col = cb * 256 + lane * 4;
        f32x4 m = {0.f, 0.f, 0.f, 0.f};
        f32x4 v[16];
#pragma unroll
        for (int kk = 0; kk < 16; ++kk) v[kk] = *(const f32x4*)(W + (size_t)(kb * 64 + 4 * kk) * N + col);
#pragma unroll
        for (int kk = 0; kk < 16; ++kk) { const float gg = g ? g[kb * 64 + 4 * kk] : 1.f;
#pragma unroll
            for (int e = 0; e < 4; ++e) m[e] = fmaxf(m[e], fabsf(v[kk][e] * gg)); }
#pragma unroll
        for (int e = 0; e < 4; ++e) atomicMax(cmax + col + e, __float_as_uint(m[e] * CMAX_SAFE)); }
}

__device__ __forceinline__ void ph_transpose_q8(const TrJob job, LAS unsigned* scr, int gw, int NGW, int lane) {
    const float* __restrict__ W = job.W; signed char* __restrict__ WQ = (signed char*)job.WT; const float* __restrict__ ks = job.kscale;
    const int ngrp = job.nrows / 64, nitems = (job.K / 64) * ngrp;
    for (int item = gw; item < nitems; item += NGW) {
        const int kb = item / ngrp, gq = item % ngrp, k0 = 64 * kb, r0 = 64 * gq, sb = srcbase_of(job.kind, r0);
        const int n4 = (lane & 15) * 4; const bool inb = sb + n4 < job.N;
        f32x4 isc = {0.f, 0.f, 0.f, 0.f};
        if (inb) { const f32x4 cm = *(const f32x4*)(job.qmax + sb + n4);
#pragma unroll
            for (int e = 0; e < 4; ++e) isc[e] = cm[e] > 0.f ? 127.f / cm[e] : 0.f; }
        f32x4 v[4][4];
#pragma unroll
        for (int i = 0; i < 4; ++i) { const int kq = 4 * i + (lane >> 4);
#pragma unroll
            for (int q = 0; q < 4; ++q) { const int k = k0 + 4 * kq + q; f32x4 t = {0.f, 0.f, 0.f, 0.f};
                if (inb) t = *(const f32x4*)(W + (size_t)k * job.N + sb + n4);
                v[i][q] = t; } }
        asm volatile("" ::: "memory");
        { float kv[4][4];
#pragma unroll
          for (int i = 0; i < 4; ++i) { const int kq = 4 * i + (lane >> 4);
#pragma unroll
              for (int q = 0; q < 4; ++q) { const int k = k0 + 4 * kq + q; kv[i][q] = (ks && k < job.kscale_n) ? ks[k] : 1.f; } }
#pragma unroll
          for (int i = 0; i < 4; ++i)
#pragma unroll
              for (int q = 0; q < 4; ++q) v[i][q] = v[i][q] * isc * kv[i][q]; }
#pragma unroll
        for (int i = 0; i < 4; ++i) { const int kq = 4 * i + (lane >> 4);
#pragma unroll
            for (int e = 0; e < 4; ++e) { const int b0 = (int)rintf(fminf(fmaxf(v[i][0][e], -127.f), 127.f)), b1 = (int)rintf(fminf(fmaxf(v[i][1][e], -127.f), 127.f)), b2 = (int)rintf(fminf(fmaxf(v[i][2][e], -127.f), 127.f)), b3 = (int)rintf(fminf(fmaxf(v[i][3][e], -127.f), 127.f));
                scr[kq * 65 + n4 + e] = (unsigned)(b0 & 255) | ((unsigned)(b1 & 255) << 8) | ((unsigned)(b2 & 255) << 16) | ((unsigned)b3 << 24); } }
        asm volatile("s_waitcnt lgkmcnt(0)" ::: "memory");
        const int c = lane & 3;
#pragma unroll
        for (int j = 0; j < 4; ++j) { const int n = (lane >> 2) + 16 * j; const int sc = colmap(job.kind, r0 + n) - sb;
            u32x4 o = {0u, 0u, 0u, 0u};
            if (sc >= 0) { o.x = scr[(4 * c + 0) * 65 + sc]; o.y = scr[(4 * c + 1) * 65 + sc]; o.z = scr[(4 * c + 2) * 65 + sc]; o.w = scr[(4 * c + 3) * 65 + sc]; }
            *(u32x4*)(WQ + (size_t)(r0 + n) * job.K + k0 + 16 * c) = o; }
        asm volatile("s_waitcnt lgkmcnt(0)" ::: "memory");
    }
}
typedef float f32x16 __attribute__((ext_vector_type(16)));
typedef short bf16x8 __attribute__((ext_vector_type(8)));
typedef short s16x4 __attribute__((ext_vector_type(4)));
#define MFMA32(a, b, c) __builtin_amdgcn_mfma_f32_32x32x16_bf16((a), (b), (c), 0, 0, 0)
constexpr int SSD_XT = 0, SSD_BT = 65536, SSD_CT = 98304, SSD_DT = 132096, SSD_ACS = SSD_DT + 2048;
constexpr size_t WS_STATES = WS_Y, WS_PREV = WS_XACT, WS_CDEC = WS_RS0 + 65536;

__device__ __forceinline__ unsigned off_b(unsigned row, unsigned ch) { return 256u * row + 16u * (ch ^ (((row & 3) << 2) | ((row >> 2) & 3))); }
__device__ __forceinline__ bf16x8 lds_row8(LAS const unsigned char* tile, unsigned row, unsigned ch) { return *(LAS const bf16x8*)(tile + off_b(row, ch)); }
__device__ __forceinline__ s16x4 lds_tr4(LAS const unsigned char* tile, unsigned rowbase, unsigned c32, unsigned lane) {
    const unsigned blk = (lane >> 4) & 1, q = (lane & 15) >> 2, p = lane & 3;
    LAS const unsigned char* a = tile + off_b(rowbase + q, 4 * c32 + 2 * blk + (p >> 1)) + 8 * (p & 1);
    return __builtin_bit_cast(s16x4, __builtin_amdgcn_ds_read_tr16_b64_v4i16((LAS s16x4*)a));
}
__device__ __forceinline__ bf16x8 cat4(const s16x4 a, const s16x4 b) { return __builtin_shufflevector(a, b, 0, 1, 2, 3, 4, 5, 6, 7); }
__device__ __forceinline__ float bfs2f(short s) { return __uint_as_float(((unsigned)(unsigned short)s) << 16); }

template <bool NEED_C>
__device__ __forceinline__ void ssd_stage(LAS unsigned char* lds, const bf16_t* XBC, const float* cw, const float* cb, const float* DT, const float* a_log, int c, int g, int tid, int lane, int wave) {
    {
        const int cgi = tid & 63, seg = tid >> 6;
        int col, tch; LAS unsigned char* tile;
        if (cgi < 32) { col = g * 256 + cgi * 8; tile = lds + SSD_XT + (cgi >> 4) * 32768; tch = cgi & 15; }
        else if (cgi < 48) { col = 2048 + g * 128 + (cgi - 32) * 8; tile = lds + SSD_BT; tch = cgi - 32; }
        else { col = 3072 + g * 128 + (cgi - 48) * 8; tile = lds + SSD_CT; tch = cgi - 48; }
        if (NEED_C || cgi < 48) {
            float w[4][8], b[8], xw[3][8];
#pragma unroll
            for (int k = 0; k < 4; ++k) { const f32x4 w0 = *(const f32x4*)(cw + k * XBCC + col), w1 = *(const f32x4*)(cw + k * XBCC + col + 4);
#pragma unroll
                for (int e = 0; e < 4; ++e) { w[k][e] = w0[e]; w[k][4 + e] = w1[e]; } }
            { const f32x4 b0 = *(const f32x4*)(cb + col), b1 = *(const f32x4*)(cb + col + 4);
#pragma unroll
              for (int e = 0; e < 4; ++e) { b[e] = b0[e]; b[4 + e] = b1[e]; } }
            const int t0 = c * 128 + seg * 16;
            u32x4 raw[19];
#pragma unroll
            for (int k = 0; k < 19; ++k) { const int tt = t0 - 3 + k;
                if (k >= 3 || tt >= 0) raw[k] = *(const u32x4*)(XBC + (size_t)tt * XBCC + col);
                else raw[k] = (u32x4){0u, 0u, 0u, 0u}; }
            asm volatile("" ::: "memory");
#pragma unroll
            for (int k = 0; k < 3; ++k) unpack8(raw[k], xw[k]);
#pragma unroll
            for (int i = 0; i < 16; ++i) { float xv[8]; unpack8(raw[3 + i], xv);
                float o[8];
#pragma unroll
                for (int e = 0; e < 8; ++e) { o[e] = silu_f(b[e] + w[0][e] * xw[0][e] + w[1][e] * xw[1][e] + w[2][e] * xw[2][e] + w[3][e] * xv[e]); xw[0][e] = xw[1][e]; xw[1][e] = xw[2][e]; xw[2][e] = xv[e]; }
                u32x4 pk; pk.x = cvt_pk_bf16(o[0], o[1]); pk.y = cvt_pk_bf16(o[2], o[3]); pk.z = cvt_pk_bf16(o[4], o[5]); pk.w = cvt_pk_bf16(o[6], o[7]);
                *(LAS u32x4*)(tile + off_b(seg * 16 + i, tch)) = pk; }
        }
    }
    { const int l = tid >> 2, r = tid & 3, hd = 4 * g + r; const float dtv = DT[(size_t)(c * 128 + l) * 32 + hd]; const float a = -expf(a_log[hd]);
      ((LAS float*)(lds + SSD_DT))[r * 128 + l] = dtv; ((LAS float*)(lds + SSD_ACS))[r * 128 + l] = dtv * a; }
    __syncthreads();
    if (wave < 4) { LAS float* ac = (LAS float*)(lds + SSD_ACS) + wave * 128; const float v0 = ac[2 * lane], v1 = ac[2 * lane + 1]; const float s = v0 + v1; float inc = s;
#pragma unroll
        for (int o = 1; o < 64; o <<= 1) { const float t = __shfl_up(inc, o); if (lane >= o) inc += t; }
        ac[2 * lane] = inc - s + v0; ac[2 * lane + 1] = inc; }
    __syncthreads();
}

__device__ __forceinline__ void ssd_pass1_unit(LAS unsigned char* lds, float* STATES, float* CDEC, int c, int g, int lane, int wave) {
    const int r = wave >> 1, nh = wave & 1, h = lane >> 5, hd = 4 * g + r;
    LAS const unsigned char* xt = lds + SSD_XT + (r >> 1) * 32768; const unsigned xc = 2 * (r & 1);
    LAS const unsigned char* bt = lds + SSD_BT;
    LAS const float* dtl = (LAS const float*)(lds + SSD_DT) + r * 128; LAS const float* acs = (LAS const float*)(lds + SSD_ACS) + r * 128;
    const float alast = acs[127];
    f32x16 acc[2][2];
#pragma unroll
    for (int i = 0; i < 2; ++i)
#pragma unroll
        for (int j = 0; j < 2; ++j)
#pragma unroll
            for (int e = 0; e < 16; ++e) acc[i][j][e] = 0.f;
#pragma unroll
    for (int ks = 0; ks < 8; ++ks) {
        const int lb = 16 * ks + 8 * h;
        const f32x4 d0 = *(LAS const f32x4*)(dtl + lb), d1 = *(LAS const f32x4*)(dtl + lb + 4), a0 = *(LAS const f32x4*)(acs + lb), a1 = *(LAS const f32x4*)(acs + lb + 4);
        float wg[8];
#pragma unroll
        for (int e = 0; e < 4; ++e) { wg[e] = d0[e] * __expf(alast - a0[e]); wg[4 + e] = d1[e] * __expf(alast - a1[e]); }
        bf16x8 A[2], B[2];
#pragma unroll
        for (int pt = 0; pt < 2; ++pt) A[pt] = cat4(lds_tr4(xt, lb, xc + pt, lane), lds_tr4(xt, lb + 4, xc + pt, lane));
#pragma unroll
        for (int nt = 0; nt < 2; ++nt) { const s16x4 t0 = lds_tr4(bt, lb, 2 * nh + nt, lane), t1 = lds_tr4(bt, lb + 4, 2 * nh + nt, lane);
            u32x4 pk; pk.x = cvt_pk_bf16(bfs2f(t0[0]) * wg[0], bfs2f(t0[1]) * wg[1]); pk.y = cvt_pk_bf16(bfs2f(t0[2]) * wg[2], bfs2f(t0[3]) * wg[3]);
            pk.z = cvt_pk_bf16(bfs2f(t1[0]) * wg[4], bfs2f(t1[1]) * wg[5]); pk.w = cvt_pk_bf16(bfs2f(t1[2]) * wg[6], bfs2f(t1[3]) * wg[7]);
            B[nt] = __builtin_bit_cast(bf16x8, pk); }
#pragma unroll
        for (int pt = 0; pt < 2; ++pt)
#pragma unroll
            for (int nt = 0; nt < 2; ++nt) acc[pt][nt] = MFMA32(A[pt], B[nt], acc[pt][nt]);
    }
    unsigned* So = (unsigned*)STATES + ((size_t)(c * 32 + hd) * 64) * 64;
    const bool odd = lane & 1;
#pragma unroll
    for (int pt = 0; pt < 2; ++pt)
#pragma unroll
        for (int nt = 0; nt < 2; ++nt)
#pragma unroll
            for (int i = 0; i < 16; i += 2) { const int p0 = 32 * pt + (i & 3) + 8 * (i >> 2) + 4 * h, n = 64 * nh + 32 * nt + (lane & 31);
                const float mine0 = acc[pt][nt][i], mine1 = acc[pt][nt][i + 1];
                const float got = __int_as_float(__builtin_amdgcn_update_dpp(0, __float_as_int(odd ? mine0 : mine1), 0xB1, 0xf, 0xf, true));
                const unsigned w = odd ? cvt_pk_bf16(got, mine1) : cvt_pk_bf16(mine0, got);
                So[(p0 + (odd ? 1 : 0)) * 64 + (n >> 1)] = w; }
    if (nh == 0 && lane == 0) CDEC[c * 32 + hd] = __expf(alast);
}

__device__ __forceinline__ void ssd_scan(const float* __restrict__ STATES, const float* __restrict__ CDEC, bf16_t* __restrict__ PREV, size_t gt, size_t NGT) {
    typedef float f32x2 __attribute__((ext_vector_type(2)));
    for (size_t e = gt; e < (size_t)NSH * 64 * 128 / 2; e += NGT) {
        const int hd = (int)(e >> 12);
        f32x2 s = {0.f, 0.f};
        for (int cb = 0; cb < 128; cb += 16) {
            f32x2 v[16]; float d[16];
#pragma unroll
            for (int k = 0; k < 16; ++k) { const unsigned w = ((const unsigned*)STATES + (size_t)(cb + k) * NSH * 64 * 64)[e]; v[k][0] = __uint_as_float(w << 16); v[k][1] = __uint_as_float(w & 0xffff0000u); d[k] = CDEC[(cb + k) * 32 + hd]; }
#pragma unroll
            for (int k = 0; k < 16; ++k) { ((unsigned*)(PREV + (size_t)(cb + k) * NSH * 64 * 128))[e] = cvt_pk_bf16(s[0], s[1]); s = s * d[k] + v[k]; }
        }
    }
}

__device__ __forceinline__ void ssd_pass3_unit(LAS unsigned char* lds, const bf16_t* PREV, const float* dskip, const bf16_t* Z, bf16_t* MIX, float* rss, int c, int g, int tid, int lane, int wave) {
    const int r = wave >> 1, lh = wave & 1, h = lane >> 5, l31 = lane & 31, hd = 4 * g + r;
    LAS const unsigned char* xt = lds + SSD_XT + (r >> 1) * 32768; const unsigned xc = 2 * (r & 1);
    LAS const unsigned char* bt = lds + SSD_BT; LAS const unsigned char* ct = lds + SSD_CT;
    LAS const float* dtl = (LAS const float*)(lds + SSD_DT) + r * 128; LAS const float* acs = (LAS const float*)(lds + SSD_ACS) + r * 128;
    const float Dh = dskip[hd];
    f32x16 acc[2][2];
#pragma unroll
    for (int i = 0; i < 2; ++i)
#pragma unroll
        for (int j = 0; j < 2; ++j)
#pragma unroll
            for (int e = 0; e < 16; ++e) acc[i][j][e] = 0.f;
    {
        bf16x8 P[2][8]; const bf16_t* pv = PREV + ((size_t)(c * 32 + hd) * 64) * 128;
#pragma unroll
        for (int pt = 0; pt < 2; ++pt)
#pragma unroll
            for (int ks = 0; ks < 8; ++ks) P[pt][ks] = *(const bf16x8*)(pv + (32 * pt + l31) * 128 + 16 * ks + 8 * h);
#pragma unroll
        for (int lt = 0; lt < 2; ++lt) { const int l0 = 32 * (lt ? 3 - lh : lh);
#pragma unroll
            for (int ks = 0; ks < 8; ++ks) { const bf16x8 Cf = lds_row8(ct, l0 + l31, 2 * ks + h);
#pragma unroll
                for (int pt = 0; pt < 2; ++pt) acc[lt][pt] = MFMA32(Cf, P[pt][ks], acc[lt][pt]); }
#pragma unroll
            for (int q4 = 0; q4 < 4; ++q4) { const f32x4 a = *(LAS const f32x4*)(acs + l0 + 8 * q4 + 4 * h);
#pragma unroll
                for (int e = 0; e < 4; ++e) { const float f = __expf(a[e]); acc[lt][0][4 * q4 + e] *= f; acc[lt][1][4 * q4 + e] *= f; } } }
    }
#pragma unroll
    for (int lt = 0; lt < 2; ++lt) {
        const int gl = lt ? 3 - lh : lh, l0 = 32 * gl, lrow = l0 + l31; const float acs_l = acs[lrow];
        for (int st = 0; st <= gl; ++st) { const int s0 = 32 * st;
            f32x16 X;
#pragma unroll
            for (int e = 0; e < 16; ++e) X[e] = 0.f;
#pragma unroll
            for (int ks = 0; ks < 8; ++ks) { const bf16x8 Bf = lds_row8(bt, s0 + l31, 2 * ks + h), Cf = lds_row8(ct, l0 + l31, 2 * ks + h); X = MFMA32(Bf, Cf, X); }
            float w[16];
#pragma unroll
            for (int q4 = 0; q4 < 4; ++q4) { const int sb = s0 + 8 * q4 + 4 * h; const f32x4 as = *(LAS const f32x4*)(acs + sb), ds = *(LAS const f32x4*)(dtl + sb);
#pragma unroll
                for (int e = 0; e < 4; ++e) { const int s = sb + e; float v = X[4 * q4 + e] * __expf(fminf(acs_l - as[e], 0.f)) * ds[e]; v = (s <= lrow) ? v : 0.f; v = (s == lrow) ? v + Dh : v; w[4 * q4 + e] = v; } }
#pragma unroll
            for (int kp = 0; kp < 2; ++kp) { u32x4 pk; pk.x = cvt_pk_bf16(w[8 * kp + 0], w[8 * kp + 1]); pk.y = cvt_pk_bf16(w[8 * kp + 2], w[8 * kp + 3]); pk.z = cvt_pk_bf16(w[8 * kp + 4], w[8 * kp + 5]); pk.w = cvt_pk_bf16(w[8 * kp + 6], w[8 * kp + 7]);
                const bf16x8 Wf = __builtin_bit_cast(bf16x8, pk); const int rowb = s0 + 16 * kp + 4 * h;
#pragma unroll
                for (int pt = 0; pt < 2; ++pt) { const bf16x8 Xf = cat4(lds_tr4(xt, rowb, xc + pt, lane), lds_tr4(xt, rowb + 8, xc + pt, lane)); acc[lt][pt] = MFMA32(Wf, Xf, acc[lt][pt]); } }
        }
    }
    __syncthreads();
    const int row = tid >> 2, qd = tid & 3; const size_t trow = (size_t)(c * 128 + row);
    {
        const bf16_t* zp = Z + trow * DSSM + g * 256 + qd * 64;
#pragma unroll
        for (int j = 0; j < 8; ++j) *(LAS u32x4*)(lds + row * 512 + qd * 128 + j * 16) = *(const u32x4*)(zp + j * 8);
    }
    __syncthreads();
#pragma unroll
    for (int lt = 0; lt < 2; ++lt)
#pragma unroll
        for (int pt = 0; pt < 2; ++pt)
#pragma unroll
            for (int i = 0; i < 16; ++i) { const int l = 32 * (lt ? 3 - lh : lh) + (i & 3) + 8 * (i >> 2) + 4 * h, col = 64 * r + 32 * pt + l31;
                LAS unsigned short* zp = (LAS unsigned short*)(lds + l * 512 + col * 2); const float zv = bf2f(*zp);
                *zp = (unsigned short)(cvt_pk_bf16(acc[lt][pt][i] * silu_f(zv), 0.f) & 0xffffu); }
    __syncthreads();
    {
        bf16_t* op = MIX + trow * DM + g * 256 + qd * 64; float ss = 0.f;
#pragma unroll
        for (int j = 0; j < 8; ++j) { const u32x4 v = *(LAS const u32x4*)(lds + row * 512 + qd * 128 + j * 16); float f[8]; unpack8(v, f);
#pragma unroll
            for (int e = 0; e < 8; ++e) ss += f[e] * f[e];
            *(u32x4*)(op + j * 8) = v; }
        ss += __shfl_xor(ss, 1); ss += __shfl_xor(ss, 2);
        if (qd == 0) unsafeAtomicAdd(rss + trow, ss);
    }
    __syncthreads();
}
constexpr int ATT_K = 0, ATT_V = 32768;
__device__ __forceinline__ unsigned off64(unsigned row, unsigned ch) { return 128u * row + 16u * (ch ^ (row & 7)); }
__device__ __forceinline__ s16x4 lds_tr4_64(LAS const unsigned char* tile, unsigned rowbase, unsigned c32, unsigned lane) {
    const unsigned blk = (lane >> 4) & 1, q = (lane & 15) >> 2, p = lane & 3;
    LAS const unsigned char* a = tile + off64(rowbase + q, 4 * c32 + 2 * blk + (p >> 1)) + 8 * (p & 1);
    return __builtin_bit_cast(s16x4, __builtin_amdgcn_ds_read_tr16_b64_v4i16((LAS s16x4*)a));
}
__device__ __forceinline__ void attn_unit(LAS unsigned char* lds, const bf16_t* Q, const bf16_t* Kb, const bf16_t* V, const float* sinks, bf16_t* MIX, int nb, int kv, int tid, int lane, int wave) {
    const int hq = kv * 8 + wave, h = lane >> 5, l31 = lane & 31;
    bf16x8 Qf[4];
#pragma unroll
    for (int ks = 0; ks < 4; ++ks) Qf[ks] = *(const bf16x8*)(Q + (size_t)(128 * nb + l31) * 2048 + hq * 64 + 16 * ks + 8 * h);
#pragma unroll
    for (int j = 0; j < 4; ++j) { const int idx = tid + 512 * j, row = idx >> 3, ch = idx & 7; int tok = 128 * (nb - 1) + row; tok = tok < 0 ? 0 : tok;
        const size_t go = (size_t)tok * 256 + kv * 64 + ch * 8;
        *(LAS u32x4*)(lds + ATT_K + off64(row, ch)) = *(const u32x4*)(Kb + go);
        *(LAS u32x4*)(lds + ATT_V + off64(row, ch)) = *(const u32x4*)(V + go); }
    __syncthreads();
    const float sink = sinks[hq];
    LAS const unsigned char* kt_ = lds + ATT_K; LAS const unsigned char* vt_ = lds + ATT_V;
    for (int sb = 0; sb < 4; ++sb) {
        const size_t qrow = (size_t)(128 * nb + 32 * sb + l31);
        f32x16 S[5];
#pragma unroll
        for (int rel = 0; rel < 5; ++rel) {
#pragma unroll
            for (int e = 0; e < 16; ++e) S[rel][e] = 0.f;
#pragma unroll
            for (int ks = 0; ks < 4; ++ks) { const bf16x8 Kf = *(LAS const bf16x8*)(kt_ + off64(32 * (sb + rel) + l31, 2 * ks + h)); S[rel] = MFMA32(Kf, Qf[ks], S[rel]); }
        }
        if (sb < 3) {
#pragma unroll
            for (int ks = 0; ks < 4; ++ks) Qf[ks] = *(const bf16x8*)(Q + (qrow + 32) * 2048 + hq * 64 + 16 * ks + 8 * h); }
        float m = -1e30f;
#pragma unroll
        for (int rel = 0; rel < 5; ++rel) { const bool tile_ok = (nb > 0) || (sb + rel >= 4);
#pragma unroll
            for (int i = 0; i < 16; ++i) { const int kr = (i & 3) + 8 * (i >> 2) + 4 * h; bool ok = tile_ok;
                if (rel == 0) ok = ok && (kr > l31);
                if (rel == 4) ok = ok && (kr <= l31);
                const float s = ok ? S[rel][i] * 0.125f : -1e30f; S[rel][i] = s; m = fmaxf(m, s); } }
        m = fmaxf(m, __shfl_xor(m, 32)); m = fmaxf(m, sink);
        float lsum = 0.f;
#pragma unroll
        for (int rel = 0; rel < 5; ++rel)
#pragma unroll
            for (int i = 0; i < 16; ++i) { const float p = __expf(S[rel][i] - m); S[rel][i] = p; lsum += p; }
        lsum += __shfl_xor(lsum, 32); lsum += __expf(sink - m);
        f32x16 O[2];
#pragma unroll
        for (int dt = 0; dt < 2; ++dt)
#pragma unroll
            for (int e = 0; e < 16; ++e) O[dt][e] = 0.f;
#pragma unroll
        for (int rel = 0; rel < 5; ++rel)
#pragma unroll
            for (int kp = 0; kp < 2; ++kp) { u32x4 pk; pk.x = cvt_pk_bf16(S[rel][8 * kp + 0], S[rel][8 * kp + 1]); pk.y = cvt_pk_bf16(S[rel][8 * kp + 2], S[rel][8 * kp + 3]);
                pk.z = cvt_pk_bf16(S[rel][8 * kp + 4], S[rel][8 * kp + 5]); pk.w = cvt_pk_bf16(S[rel][8 * kp + 6], S[rel][8 * kp + 7]);
                const bf16x8 Pf = __builtin_bit_cast(bf16x8, pk); const int rowb = 32 * (sb + rel) + 16 * kp + 4 * h;
#pragma unroll
                for (int dt = 0; dt < 2; ++dt) { const bf16x8 Vf = cat4(lds_tr4_64(vt_, rowb, dt, lane), lds_tr4_64(vt_, rowb + 8, dt, lane)); O[dt] = MFMA32(Vf, Pf, O[dt]); } }
        const float inv = 1.f / lsum;
        bf16_t* op = MIX + qrow * DM + 2048 + hq * 64;
#pragma unroll
        for (int dt = 0; dt < 2; ++dt)
#pragma unroll
            for (int i4 = 0; i4 < 4; ++i4) { f32x4 v; v[0] = O[dt][4 * i4] * inv; v[1] = O[dt][4 * i4 + 1] * inv; v[2] = O[dt][4 * i4 + 2] * inv; v[3] = O[dt][4 * i4 + 3] * inv;
                *(u32x2*)(op + 32 * dt + 8 * i4 + 4 * h) = pack4(v); }
    }
    __syncthreads();
}
typedef int i32x4 __attribute__((ext_vector_type(4)));
__device__ __forceinline__ f32x4 acc_i2f(const f32x4 a) { return __builtin_convertvector(__builtin_bit_cast(i32x4, a), f32x4); }
__device__ __forceinline__ u32x2 pack8_i8(const f32x4 a, const f32x4 b) {
    u32x2 w; w.x = (unsigned)((int)a[0] & 255) | ((unsigned)((int)a[1] & 255) << 8) | ((unsigned)((int)a[2] & 255) << 16) | ((unsigned)(int)a[3] << 24);
    w.y = (unsigned)((int)b[0] & 255) | ((unsigned)((int)b[1] & 255) << 8) | ((unsigned)((int)b[2] & 255) << 16) | ((unsigned)(int)b[3] << 24); return w; }
struct EpiInProj {
    static constexpr bool I8 = false, APERM = false, PERM = false, AFTER_DRAIN = false, HAS_MID = false; int tmid;
    bf16_t *Q, *Kb, *V, *Z, *XBC; float* DT; const float *rs0, *cosT, *sinT, *dt_bias;
    __device__ __forceinline__ void mid(f32x4 (&)[2][2][4][2], const pg8::Unit&, int, int) const {}
    __device__ __forceinline__ void operator()(const f32x4 (&acc)[2][2][4][2], const pg8::Unit& u, int wr, int wc, int fr, int fq) const {
        const int row0 = u.pm * 256 + wr * 64 + fr, pn = u.pn;
        if (pn < 9) {
            bf16_t* base = pn < 8 ? Q : Kb; const int ld = pn < 8 ? 2048 : 256, hb = pn < 8 ? pn * 4 : 0, dlo = 16 * (wc & 1) + 4 * fq;
#pragma unroll
            for (int ai = 0; ai < 2; ++ai) {
                float sv[4]; f32x4 cv[4], sn[4];
#pragma unroll
                for (int m = 0; m < 4; ++m) { const int row = row0 + ai * 128 + m * 16; sv[m] = rs0[row];
                    cv[m] = *(const f32x4*)(cosT + (size_t)row * 32 + dlo); sn[m] = *(const f32x4*)(sinT + (size_t)row * 32 + dlo); }
                asm volatile("" ::: "memory");
#pragma unroll
                for (int m = 0; m < 4; ++m) { const int row = row0 + ai * 128 + m * 16; const float s = sv[m]; const f32x4 c4 = cv[m], s4 = sn[m];
#pragma unroll
                    for (int bj = 0; bj < 2; ++bj) { const int hh = hb + 2 * bj + (wc >> 1); const f32x4 x1 = acc[ai][bj][m][0], x2 = acc[ai][bj][m][1];
                        const f32x4 o1 = (x1 * c4 - x2 * s4) * s, o2 = (x2 * c4 + x1 * s4) * s;
                        bf16_t* dst = base + (size_t)row * ld + hh * 64 + dlo;
                        *(u32x2*)dst = pack4(o1); *(u32x2*)(dst + 32) = pack4(o2); } }
                asm volatile("" ::: "memory"); }
        } else if (pn < 34) {
            bf16_t* base; int ld, col0;
            if (pn == 9) { base = V; ld = 256; col0 = 0; } else if (pn < 18) { base = Z; ld = 2048; col0 = (pn - 10) * 256; } else { base = XBC; ld = 4096; col0 = (pn - 18) * 256; }
            col0 += wc * 32 + 8 * fq;
            float sv[2][4];
#pragma unroll
            for (int ai = 0; ai < 2; ++ai)
#pragma unroll
                for (int m = 0; m < 4; ++m) sv[ai][m] = rs0[row0 + ai * 128 + m * 16];
            asm volatile("" ::: "memory");
#pragma unroll
            for (int ai = 0; ai < 2; ++ai)
#pragma unroll
                for (int m = 0; m < 4; ++m) { const int row = row0 + ai * 128 + m * 16; const float s = sv[ai][m];
#pragma unroll
                    for (int bj = 0; bj < 2; ++bj) *(u32x4*)(base + (size_t)row * ld + col0 + bj * 128) = pack8(acc[ai][bj][m][0] * s, acc[ai][bj][m][1] * s); }
        } else if (wc == 0) {
            const f32x4 b0 = *(const f32x4*)(dt_bias + 8 * fq), b1 = *(const f32x4*)(dt_bias + 8 * fq + 4);
            float sv[2][4];
#pragma unroll
            for (int ai = 0; ai < 2; ++ai)
#pragma unroll
                for (int m = 0; m < 4; ++m) sv[ai][m] = rs0[row0 + ai * 128 + m * 16];
            asm volatile("" ::: "memory");
#pragma unroll
            for (int ai = 0; ai < 2; ++ai)
#pragma unroll
                for (int m = 0; m < 4; ++m) { const int row = row0 + ai * 128 + m * 16; const float s = sv[ai][m];
                    f32x4 v0 = acc[ai][0][m][0] * s + b0, v1 = acc[ai][0][m][1] * s + b1;
#pragma unroll
                    for (int e = 0; e < 4; ++e) { v0[e] = softplus_f(v0[e]); v1[e] = softplus_f(v1[e]); }
                    *(f32x4*)(DT + (size_t)row * 32 + 8 * fq) = v0; *(f32x4*)(DT + (size_t)row * 32 + 8 * fq + 4) = v1; }
        }
    }
};
struct EpiWo {
    static constexpr bool I8 = false, APERM = false, PERM = false, AFTER_DRAIN = false, HAS_MID = true; int tmid;
    const float* x; bf16_t* HB; const float* rss_ssm; float* rss1; signed char* HQ; const float* rs0;
    __device__ __forceinline__ void mid(f32x4 (&acc)[2][2][4][2], const pg8::Unit& u, int wr, int fr) const {
#pragma unroll
        for (int ai = 0; ai < 2; ++ai)
#pragma unroll
            for (int m = 0; m < 4; ++m) { const int row = u.pm * 256 + wr * 64 + fr + ai * 128 + m * 16; const float sc = rsqrtf(rss_ssm[row] * (1.f / DSSM) + EPS);
#pragma unroll
                for (int bj = 0; bj < 2; ++bj)
#pragma unroll
                    for (int n = 0; n < 2; ++n) acc[ai][bj][m][n] *= sc; }
    }
    __device__ __forceinline__ void operator()(const f32x4 (&acc)[2][2][4][2], const pg8::Unit& u, int wr, int wc, int fr, int fq) const {
        const int row0 = u.pm * 256 + wr * 64 + fr, col0 = u.pn * 256 + wc * 32 + 8 * fq;
#pragma unroll
        for (int ai = 0; ai < 2; ++ai)
#pragma unroll
            for (int mp = 0; mp < 2; ++mp) {
                f32x4 xr[2][2][2]; float iqv[2];
#pragma unroll
                for (int mm = 0; mm < 2; ++mm) { const int row = row0 + ai * 128 + (2 * mp + mm) * 16; iqv[mm] = rs0[row];
#pragma unroll
                    for (int bj = 0; bj < 2; ++bj) { const size_t off = (size_t)row * DM + col0 + bj * 128; xr[mm][bj][0] = *(const f32x4*)(x + off); xr[mm][bj][1] = *(const f32x4*)(x + off + 4); } }
#pragma unroll
                for (int mm = 0; mm < 2; ++mm) { const int m = 2 * mp + mm, row = row0 + ai * 128 + m * 16; float ss = 0.f; const float iq = (127.f / QCLIP) * iqv[mm];
#pragma unroll
                    for (int bj = 0; bj < 2; ++bj) { const size_t off = (size_t)row * DM + col0 + bj * 128;
                        const f32x4 h0 = xr[mm][bj][0] + acc[ai][bj][m][0], h1 = xr[mm][bj][1] + acc[ai][bj][m][1];
                        *(u32x4*)(HB + off) = pack8(h0, h1);
                        { f32x4 q0, q1;
#pragma unroll
                          for (int ee = 0; ee < 4; ++ee) { q0[ee] = fminf(fmaxf(rintf(h0[ee] * iq), -127.f), 127.f); q1[ee] = fminf(fmaxf(rintf(h1[ee] * iq), -127.f), 127.f); }
                          *(u32x2*)(HQ + off) = pack8_i8(q0, q1); }
                        ss += (h0[0] * h0[0] + h0[1] * h0[1]) + (h0[2] * h0[2] + h0[3] * h0[3]) + (h1[0] * h1[0] + h1[1] * h1[1]) + (h1[2] * h1[2] + h1[3] * h1[3]); }
                    ss += __shfl_xor(ss, 16); ss += __shfl_xor(ss, 32);
                    if (fq == 0) unsafeAtomicAdd(rss1 + row, ss); }
                asm volatile("" ::: "memory"); }
    }
};
struct EpiUpPlain {
    static constexpr bool I8 = false, APERM = false, PERM = false, AFTER_DRAIN = false, HAS_MID = false; int tmid;
    bf16_t* U; const float* rss1;
    __device__ __forceinline__ void mid(f32x4 (&)[2][2][4][2], const pg8::Unit&, int, int) const {}
    __device__ __forceinline__ void operator()(const f32x4 (&acc)[2][2][4][2], const pg8::Unit& u, int wr, int wc, int fr, int fq) const {
        const int row0 = u.pm * 256 + wr * 64 + fr, col0 = u.pn * 256 + wc * 32 + 8 * fq;
#pragma unroll
        for (int ai = 0; ai < 2; ++ai)
#pragma unroll
            for (int m = 0; m < 4; ++m) { const int row = row0 + ai * 128 + m * 16; const float s = rsqrtf(rss1[row] * (1.f / DM) + EPS);
#pragma unroll
                for (int bj = 0; bj < 2; ++bj) *(u32x4*)(U + (size_t)row * DFF + col0 + bj * 128) = pack8(acc[ai][bj][m][0] * s, acc[ai][bj][m][1] * s); }
    }
};
struct EpiDown {
    static constexpr bool I8 = false, APERM = false, PERM = false, AFTER_DRAIN = false, HAS_MID = false; int tmid;
    bf16_t* HB; signed char* HQ; const float* rss1;
    __device__ __forceinline__ void mid(f32x4 (&)[2][2][4][2], const pg8::Unit&, int, int) const {}
    __device__ __forceinline__ void operator()(const f32x4 (&acc)[2][2][4][2], const pg8::Unit& u, int wr, int wc, int fr, int fq) const {
        const int row0 = u.pm * 256 + wr * 64 + fr, col0 = u.pn * 256 + wc * 32 + 8 * fq;
#pragma unroll
        for (int ai = 0; ai < 2; ++ai) {
            u32x4 hr[4][2]; float q1v[4];
#pragma unroll
            for (int m = 0; m < 4; ++m) { q1v[m] = rss1[row0 + ai * 128 + m * 16];
#pragma unroll
                for (int bj = 0; bj < 2; ++bj) hr[m][bj] = *(const u32x4*)(HB + (size_t)(row0 + ai * 128 + m * 16) * DM + col0 + bj * 128); }
#pragma unroll
            for (int m = 0; m < 4; ++m) { const float iq = (127.f / QCLIP) * rsqrtf(q1v[m] * (1.f / DM) + EPS);
#pragma unroll
                for (int bj = 0; bj < 2; ++bj) { float hv[8]; unpack8(hr[m][bj], hv); const size_t off = (size_t)(row0 + ai * 128 + m * 16) * DM + col0 + bj * 128;
                    f32x4 h0 = acc[ai][bj][m][0], h1 = acc[ai][bj][m][1];
#pragma unroll
                    for (int e = 0; e < 4; ++e) { h0[e] += hv[e]; h1[e] += hv[4 + e]; }
                    *(u32x4*)(HB + off) = pack8(h0, h1);
                    f32x4 q0, q1;
#pragma unroll
                    for (int ee = 0; ee < 4; ++ee) { q0[ee] = fminf(fmaxf(rintf(h0[ee] * iq), -127.f), 127.f); q1[ee] = fminf(fmaxf(rintf(h1[ee] * iq), -127.f), 127.f); }
                    *(u32x2*)(HQ + off) = pack8_i8(q0, q1); } }
            asm volatile("" ::: "memory"); }
    }
};
struct EpiBf {
    static constexpr bool I8 = false, APERM = false, PERM = false, AFTER_DRAIN = false, HAS_MID = false; int tmid;
    bf16_t* O; int ldo;
    __device__ __forceinline__ void mid(f32x4 (&)[2][2][4][2], const pg8::Unit&, int, int) const {}
    __device__ __forceinline__ void operator()(const f32x4 (&acc)[2][2][4][2], const pg8::Unit& u, int wr, int wc, int fr, int fq) const {
        const int row0 = u.pm * 256 + wr * 64 + fr, col0 = u.pn * 256 + wc * 32 + 8 * fq;
#pragma unroll
        for (int ai = 0; ai < 2; ++ai)
#pragma unroll
            for (int m = 0; m < 4; ++m) { const int row = row0 + ai * 128 + m * 16;
#pragma unroll
                for (int bj = 0; bj < 2; ++bj) *(u32x4*)(O + (size_t)row * ldo + col0 + bj * 128) = pack8(acc[ai][bj][m][0], acc[ai][bj][m][1]); }
    }
};
struct EpiGate {
    static constexpr bool I8 = true, APERM = false, PERM = false, AFTER_DRAIN = false, HAS_MID = false; int tmid;
    float* H; const bf16_t* HB; const bf16_t* PP; const float* bg; float* rss3; const float* rss1; const float* cmax;
    __device__ __forceinline__ void mid(f32x4 (&)[2][2][4][2], const pg8::Unit&, int, int) const {}
    __device__ __forceinline__ void operator()(const f32x4 (&acc)[2][2][4][2], const pg8::Unit& u, int wr, int wc, int fr, int fq) const {
        const int row0 = u.pm * 256 + wr * 64 + fr, col0 = u.pn * 256 + wc * 32 + 8 * fq;
        f32x4 bv[2][2], sb[2][2];
#pragma unroll
        for (int bj = 0; bj < 2; ++bj) { bv[bj][0] = *(const f32x4*)(bg + col0 + bj * 128); bv[bj][1] = *(const f32x4*)(bg + col0 + bj * 128 + 4);
            sb[bj][0] = *(const f32x4*)(cmax + col0 + bj * 128) * (1.f / 127.f); sb[bj][1] = *(const f32x4*)(cmax + col0 + bj * 128 + 4) * (1.f / 127.f); }
#pragma unroll
        for (int ai = 0; ai < 2; ++ai)
#pragma unroll
            for (int mp = 0; mp < 2; ++mp) {
                u32x4 hr[2][2], pr[2][2]; float q1v[2];
#pragma unroll
                for (int mm = 0; mm < 2; ++mm) { const int row = row0 + ai * 128 + (2 * mp + mm) * 16; q1v[mm] = rss1[row];
#pragma unroll
                    for (int bj = 0; bj < 2; ++bj) { const size_t off = (size_t)row * DM + col0 + bj * 128; hr[mm][bj] = *(const u32x4*)(HB + off); pr[mm][bj] = *(const u32x4*)(PP + off); } }
#pragma unroll
                for (int mm = 0; mm < 2; ++mm) { const int m = 2 * mp + mm, row = row0 + ai * 128 + m * 16; float ss = 0.f; const float sa = (QCLIP / 127.f) * sqrtf(q1v[mm] * (1.f / DM) + EPS);
#pragma unroll
                    for (int bj = 0; bj < 2; ++bj) { const size_t off = (size_t)row * DM + col0 + bj * 128;
                        float pv[8], hv[8]; unpack8(pr[mm][bj], pv); unpack8(hr[mm][bj], hv);
                        const f32x4 g0 = acc_i2f(acc[ai][bj][m][0]) * (sb[bj][0] * sa) + bv[bj][0], g1 = acc_i2f(acc[ai][bj][m][1]) * (sb[bj][1] * sa) + bv[bj][1]; f32x4 h0, h1;
#pragma unroll
                        for (int e = 0; e < 4; ++e) { h0[e] = hv[e] + pv[e] * sigm_f(g0[e]); h1[e] = hv[4 + e] + pv[4 + e] * sigm_f(g1[e]); }
                        *(f32x4*)(H + off) = h0; *(f32x4*)(H + off + 4) = h1;
                        ss += (h0[0] * h0[0] + h0[1] * h0[1]) + (h0[2] * h0[2] + h0[3] * h0[3]) + (h1[0] * h1[0] + h1[1] * h1[1]) + (h1[2] * h1[2] + h1[3] * h1[3]); }
                    ss += __shfl_xor(ss, 16); ss += __shfl_xor(ss, 32);
                    if (fq == 0) unsafeAtomicAdd(rss3 + row, ss); }
                asm volatile("" ::: "memory"); }
    }
};


__device__ __forceinline__ float dpp_shr1z(float src) { return __int_as_float(__builtin_amdgcn_update_dpp(0, __float_as_int(src), 0x111, 0xf, 0xf, true)); }
__device__ __forceinline__ f32x4 shr1z4(const f32x4 a) { f32x4 r; r[0] = dpp_shr1z(a[0]); r[1] = dpp_shr1z(a[1]); r[2] = dpp_shr1z(a[2]); r[3] = dpp_shr1z(a[3]); return r; }
struct EpiUpConv {
    static constexpr bool I8 = true, APERM = true, PERM = false, AFTER_DRAIN = false, HAS_MID = false; int tmid;
    bf16_t* ACT; const float* rss1; const float* cw; const float* cb; LAS float* X; const float* rs0; const float* cmax;
    __device__ __forceinline__ void mid(f32x4 (&)[2][2][4][2], const pg8::Unit&, int, int) const {}
    __device__ __forceinline__ void conv4(f32x4 (&y)[4], const f32x4 (&x)[4], LAS const float* wl) const {
        const f32x4 w0 = *(LAS const f32x4*)wl, w1 = *(LAS const f32x4*)(wl + 128), w2 = *(LAS const f32x4*)(wl + 256), b = *(LAS const f32x4*)(wl + 384);
        const f32x4 x1 = shr1z4(x[3]), x2 = shr1z4(x[2]);
        y[0] = b + w2 * x[0] + w1 * x1 + w0 * x2;
        y[1] = b + w2 * x[1] + w1 * x[0] + w0 * x1;
        y[2] = b + w2 * x[2] + w1 * x[1] + w0 * x[0];
        y[3] = b + w2 * x[3] + w1 * x[2] + w0 * x[1];
    }
    __device__ __forceinline__ void operator()(const f32x4 (&acc)[2][2][4][2], const pg8::Unit& u, int wr, int wc, int fr, int fq) const {
        const int T0 = 254 * u.pm - 2, colp = wc * 32 + 8 * fq, cbase = u.pn * 128 + colp;
        LAS float* WL = X + 2048;
        typedef float f32x2 __attribute__((ext_vector_type(2)));
        const int tid = (wr * 4 + wc) * 64 + fq * 16 + fr, q = tid >> 6, c2 = (tid & 63) * 2, gu = q >> 2, k = q & 3;
        const float* src = (k < 3 ? cw + (size_t)k * 2 * DFF : cb) + gu * DFF + u.pn * 128 + c2;
        f32x2 wv = *(const f32x2*)src;
        const f32x2 cm = *(const f32x2*)(cmax + gu * DFF + u.pn * 128 + c2);
        float qv[2][4], r0v[2][4];
#pragma unroll
        for (int ai = 0; ai < 2; ++ai)
#pragma unroll
            for (int m = 0; m < 4; ++m) { const int t = T0 + ai * 128 + wr * 64 + 4 * fr + m; const int tc = ((t >= 0) && (t < SEQ)) ? t : 0; qv[ai][m] = rss1[tc]; r0v[ai][m] = rs0[tc]; }
        asm volatile("" ::: "memory");
        if (k < 3) wv = wv * cm * (1.f / 127.f);
        *(LAS f32x2*)(WL + q * 128 + c2) = wv;
        float rs[2][4];
#pragma unroll
        for (int ai = 0; ai < 2; ++ai)
#pragma unroll
            for (int m = 0; m < 4; ++m) { const int t = T0 + ai * 128 + wr * 64 + 4 * fr + m; const bool ok = (t >= 0) && (t < SEQ);
                rs[ai][m] = ok ? rsqrtf(qv[ai][m] * (1.f / DM) + EPS) * (QCLIP / 127.f) * __builtin_amdgcn_rcpf(r0v[ai][m]) : 0.f; }
        if (fr == 15) {
#pragma unroll
            for (int ai = 0; ai < 2; ++ai)
#pragma unroll
                for (int bj = 0; bj < 2; ++bj)
#pragma unroll
                    for (int n = 0; n < 2; ++n) { *(LAS f32x4*)(X + ((2 * ai + wr) * 2 + 0) * 256 + bj * 128 + colp + 4 * n) = acc_i2f(acc[ai][bj][2][n]) * rs[ai][2];
                                                  *(LAS f32x4*)(X + ((2 * ai + wr) * 2 + 1) * 256 + bj * 128 + colp + 4 * n) = acc_i2f(acc[ai][bj][3][n]) * rs[ai][3]; }
        }
        asm volatile("s_waitcnt lgkmcnt(0)" ::: "memory"); __builtin_amdgcn_s_barrier(); asm volatile("" ::: "memory");
#pragma unroll
        for (int ai = 0; ai < 2; ++ai) {
            const int pb = 2 * ai + wr - 1;
#pragma unroll
            for (int n = 0; n < 2; ++n) {
                const int cl = colp + 4 * n, cch = cbase + 4 * n;
                asm volatile("" ::: "memory");
                f32x4 yg[4], yu[4];
                { f32x4 x[4];
#pragma unroll
                  for (int m = 0; m < 4; ++m) x[m] = acc_i2f(acc[ai][0][m][n]) * rs[ai][m];
                  conv4(yg, x, WL + cl); }
                asm volatile("" : "+v"(yg[0]), "+v"(yg[1]), "+v"(yg[2]), "+v"(yg[3]) :: "memory");
                { f32x4 x[4];
#pragma unroll
                  for (int m = 0; m < 4; ++m) x[m] = acc_i2f(acc[ai][1][m][n]) * rs[ai][m];
                  conv4(yu, x, WL + 512 + cl); }
                if (fr == 0 && pb >= 0) {
                    const f32x4 h1g = *(LAS const f32x4*)(X + (pb * 2 + 1) * 256 + cl), h2g = *(LAS const f32x4*)(X + (pb * 2) * 256 + cl);
                    const f32x4 h1u = *(LAS const f32x4*)(X + (pb * 2 + 1) * 256 + 128 + cl), h2u = *(LAS const f32x4*)(X + (pb * 2) * 256 + 128 + cl);
                    const f32x4 g0 = *(LAS const f32x4*)(WL + cl), g1 = *(LAS const f32x4*)(WL + 128 + cl), u0 = *(LAS const f32x4*)(WL + 512 + cl), u1 = *(LAS const f32x4*)(WL + 640 + cl);
                    yg[0] += g1 * h1g + g0 * h2g; yg[1] += g0 * h1g; yu[0] += u1 * h1u + u0 * h2u; yu[1] += u0 * h1u;
                }
#pragma unroll
                for (int m = 0; m < 4; ++m) { const int R = ai * 128 + wr * 64 + 4 * fr + m, t = T0 + R; f32x4 o;
#pragma unroll
                    for (int e = 0; e < 4; ++e) o[e] = silu_f(yg[m][e]) * yu[m][e];
                    if (R >= 2 && t < SEQ) *(u32x2*)(ACT + (size_t)t * DFF + cch) = pack4(o); }
            }
        }
    }
};
constexpr int LDS_BYTES = 147456;
constexpr int RING_BYTES = 131072, MISC_OFF = RING_BYTES + 320;
constexpr int N_PHASES = 10;
struct Args { const float* in[22]; float* out; unsigned char* ws; int ph_lo, ph_hi, li, pad; };
struct PpOrder {
    int c, G;
    __device__ __forceinline__ bool next(int i, pg8::Unit& u) const {
        int L;
        if (G == 256) { if (c < 192) { if (i >= 2) return false; L = c * 2 + i; } else { if (i >= 10) return false; L = 384 + (c - 192) * 10 + i; } }
        else { L = i * G + c; if (L >= 1024) return false; }
        u.pm = L >> 4; u.pn = L & 15; return true;
    }
    __device__ __forceinline__ void a_ready(const pg8::Unit&) const {}
    __device__ __forceinline__ void done(const pg8::Unit&) const {}
};
typedef const __attribute__((address_space(4))) Args* ArgsP;
__device__ __forceinline__ ArgsP fresh_args() { ArgsP p = (ArgsP)__builtin_amdgcn_kernarg_segment_ptr(); asm volatile("" : "+s"(p)); return p; }
__device__ __forceinline__ int fresh_tid() { int t = threadIdx.x; asm volatile("" : "+v"(t)); return t; }
#define PH_IDS() ArgsP ap = fresh_args(); unsigned char* ws = ap->ws; float* ctl = (float*)(ws + WS_CTL); const int tid = fresh_tid(), lane = tid & 63, wave = __builtin_amdgcn_readfirstlane(tid >> 6); \
    const int G = gridDim.x, c = blockIdx.x, gw = c * 8 + wave, NGW = G * 8; const size_t gt = (size_t)c * 512 + tid, NGT = (size_t)G * 512; \
    (void)ctl; (void)lane; (void)gw; (void)NGW; (void)gt; (void)NGT; (void)ws
__global__ void __launch_bounds__(512, 2) k_fwd(Args a_unused) {
    extern __shared__ __attribute__((aligned(16))) unsigned char lds_raw[];
    LAS unsigned char* lds = (LAS unsigned char*)lds_raw;
    int lo, hi;
    XcdBarrier bar;
    {   PH_IDS();
        volatile LAS unsigned* MISC = (volatile LAS unsigned*)(lds + MISC_OFF);
        for (int u = tid; u < (LDS_BYTES - RING_BYTES) / 4; u += 512) ((LAS unsigned*)(lds + RING_BYTES))[u] = 0u;
        __syncthreads();
        bar = xcd_barrier_post((unsigned*)ctl + CW_BAR + ap->li * XCD_BAR_WORDS, MISC + 8);
        lo = ap->ph_lo; hi = ap->ph_hi; }
#define IN(k) (lo <= (k) && (k) < hi)
#define SEAM(k) do { if (IN(k) && IN((k) + 1)) xcd_barrier(bar); } while (0)

    if (IN(0)) { PH_IDS();
        LAS unsigned* scr = (LAS unsigned*)(lds + wave * 16384);
        TrJob j; j.pad = 0; j.qmax = nullptr;
        j.W = ap->in[4]; j.WT = (bf16_t*)(ws + WS_WIN); j.kscale = ap->in[3]; j.K = DM; j.N = NPROJ; j.nrows = NPROJ_PAD; j.kind = 1; j.kxor = 0; j.kscale_n = DM; ph_transpose(j, scr, gw, NGW, lane);
        j.kscale = nullptr; j.K = DM; j.N = DM; j.nrows = DM; j.kind = 0; j.kxor = 0; j.kscale_n = 0;
        j.W = ap->in[20]; j.WT = (bf16_t*)(ws + WS_WP); j.K = PLE; ph_transpose(j, scr, gw, NGW, lane);
        ph_xprep(ap->in[0], (bf16_t*)(ws + WS_XB), (float*)(ws + WS_RS0), gw, NGW, lane);
        ph_pprep(ap->in[1], (bf16_t*)(ws + WS_PB), gt, NGT);
        ph_trig((const int*)ap->in[2], (float*)(ws + WS_COS), (float*)(ws + WS_SIN), gt, NGT);
    }
    SEAM(0);
    if (IN(1)) { PH_IDS();
        { pg8::Gemm g{(const bf16_t*)(ws + WS_XB), (const bf16_t*)(ws + WS_WIN), SEQ, NPROJ_PAD, DM}; pg8::StaticOrder S; S.init(SEQ, NPROJ_PAD, G, c);
          EpiInProj E{0, (bf16_t*)(ws + WS_Q), (bf16_t*)(ws + WS_K), (bf16_t*)(ws + WS_V), (bf16_t*)(ws + WS_Z), (bf16_t*)(ws + WS_XBC), (float*)(ws + WS_DT),
                      (const float*)(ws + WS_RS0), (const float*)(ws + WS_COS), (const float*)(ws + WS_SIN), ap->in[8]};
          pg8::gemm_phase<EpiInProj, pg8::StaticOrder, true, true>(lds, g, S, E); }
        { pg8::Gemm g{(const bf16_t*)(ws + WS_PB), (const bf16_t*)(ws + WS_WP), SEQ, DM, PLE}; PpOrder S{c, G};
          EpiBf E{0, (bf16_t*)(ws + WS_PP), DM};
          pg8::gemm_phase<EpiBf, PpOrder, true, true>(lds, g, S, E); }
    }
    SEAM(1);
    if (IN(2)) { PH_IDS();
        for (int u = c; u < 512; u += G) attn_unit(lds, (const bf16_t*)(ws + WS_Q), (const bf16_t*)(ws + WS_K), (const bf16_t*)(ws + WS_V), ap->in[5], (bf16_t*)(ws + WS_MIX), u >> 2, u & 3, tid, lane, wave);
        for (int u = c; u < 1024; u += G) { const int ch = u >> 3, g = u & 7;
            ssd_stage<false>(lds, (const bf16_t*)(ws + WS_XBC), ap->in[6], ap->in[7], (const float*)(ws + WS_DT), ap->in[9], ch, g, tid, lane, wave);
            ssd_pass1_unit(lds, (float*)(ws + WS_STATES), (float*)(ws + WS_CDEC), ch, g, lane, wave);
            __syncthreads(); }
    }
    if (IN(2)) { PH_IDS();
        ph_colmax(ap->in[14], ap->in[13], DM, 2 * DFF, (unsigned*)ctl + CW_CMAX_UP, gw, NGW, lane);
        ph_colmax(ap->in[18], nullptr, DM, DM, (unsigned*)ctl + CW_CMAX_G, gw, NGW, lane);
    }
    SEAM(2);
    if (IN(3)) { PH_IDS(); ssd_scan((const float*)(ws + WS_STATES), (const float*)(ws + WS_CDEC), (bf16_t*)(ws + WS_PREV), gt, NGT); }
    SEAM(3);
    if (IN(4)) {
        for (int s = 0; s < 3; ++s) {
            const bool copy_first = ((blockIdx.x >> 3) & 1) != 0;
            if (s == 1) { PH_IDS();
                for (int u = c; u < 1024; u += G) { const int ch = u >> 3, g = u & 7;
                    ssd_stage<true>(lds, (const bf16_t*)(ws + WS_XBC), ap->in[6], ap->in[7], (const float*)(ws + WS_DT), ap->in[9], ch, g, tid, lane, wave);
                    ssd_pass3_unit(lds, (const bf16_t*)(ws + WS_PREV), ap->in[10], (const bf16_t*)(ws + WS_Z), (bf16_t*)(ws + WS_MIX), ctl + CW_RSS_SSM, ch, g, tid, lane, wave); }
            } else if ((s == 0) == copy_first) { PH_IDS();
                LAS unsigned* scr = (LAS unsigned*)(lds + wave * 16384);
                TrJob j; j.pad = 0; j.qmax = nullptr;
                j.W = ap->in[12]; j.WT = (bf16_t*)(ws + WS_WO); j.kscale = ap->in[11]; j.K = DM; j.N = DM; j.nrows = DM; j.kind = 0; j.kxor = 2048; j.kscale_n = 2048; ph_transpose(j, scr, gw, NGW, lane);
                j.qmax = ctl + CW_CMAX_UP; j.W = ap->in[14]; j.WT = (bf16_t*)(ws + WS_WUP); j.kscale = ap->in[13]; j.K = DM; j.N = 2 * DFF; j.nrows = 2 * DFF; j.kind = 2; j.kxor = 0; j.kscale_n = DM; ph_transpose_q8(j, scr, gw, NGW, lane); j.qmax = nullptr;
                j.W = ap->in[17]; j.WT = (bf16_t*)(ws + WS_WDN); j.kscale = nullptr; j.K = DFF; j.N = DM; j.nrows = DM; j.kind = 0; j.kxor = 0; j.kscale_n = 0; ph_transpose(j, scr, gw, NGW, lane);
                j.qmax = ctl + CW_CMAX_G; j.W = ap->in[18]; j.WT = (bf16_t*)(ws + WS_WG); j.K = DM; ph_transpose_q8(j, scr, gw, NGW, lane); j.qmax = nullptr;
                __syncthreads();
            }
        }
    }
    SEAM(4);
    if (IN(5)) { PH_IDS();
        pg8::Gemm g{(const bf16_t*)(ws + WS_MIX), (const bf16_t*)(ws + WS_WO), SEQ, DM, DM}; pg8::StaticOrder S; S.init(SEQ, DM, G, c);
        EpiWo E{32, ap->in[0], (bf16_t*)(ws + WS_XB), ctl + CW_RSS_SSM, ctl + CW_RSS1, (signed char*)(ws + WS_H1Q), (const float*)(ws + WS_RS0)};
        pg8::gemm_phase<EpiWo, pg8::StaticOrder, true, true>(lds, g, S, E);
    }
    SEAM(5);
    if (IN(6)) { PH_IDS();
        pg8::Gemm g{(const bf16_t*)(ws + WS_H1Q - 2 * DM), (const bf16_t*)(ws + WS_WUP), 65 * 256, 2 * DFF, DM, (size_t)254 * DM};     pg8::StaticOrder S; S.init(65 * 256, 2 * DFF, G, c);
        EpiUpConv E{0, (bf16_t*)(ws + WS_ACT), ctl + CW_RSS1, ap->in[15], ap->in[16], (LAS float*)(lds + RING_BYTES + 1024), (const float*)(ws + WS_RS0), ctl + CW_CMAX_UP};
        pg8::gemm_phase<EpiUpConv, pg8::StaticOrder, true, true>(lds, g, S, E);
    }
    SEAM(6);
    if (IN(7)) { PH_IDS();
        pg8::Gemm g{(const bf16_t*)(ws + WS_ACT), (const bf16_t*)(ws + WS_WDN), SEQ, DM, DFF}; pg8::StaticOrder S; S.init(SEQ, DM, G, c);
        EpiDown E{0, (bf16_t*)(ws + WS_XB), (signed char*)(ws + WS_H2Q), ctl + CW_RSS1};
        pg8::gemm_phase<EpiDown, pg8::StaticOrder, true, true>(lds, g, S, E);
    }
    SEAM(7);
    if (IN(8)) { PH_IDS();
        pg8::Gemm g{(const bf16_t*)(ws + WS_H2Q), (const bf16_t*)(ws + WS_WG), SEQ, DM, DM}; pg8::StaticOrder S; S.init(SEQ, DM, G, c);
        EpiGate E{0, ap->out, (const bf16_t*)(ws + WS_XB), (const bf16_t*)(ws + WS_PP), ap->in[19], ctl + CW_RSS3, ctl + CW_RSS1, ctl + CW_CMAX_G};
        pg8::gemm_phase<EpiGate, pg8::StaticOrder, true, true>(lds, g, S, E);
    }
    SEAM(8);
    if (IN(9)) { PH_IDS(); ph_final_norm(ap->out, ctl + CW_RSS3, ap->in[21], gt, NGT); }
#undef IN
#undef SEAM
}

#ifndef MK_N_LAUNCHES
#define MK_N_LAUNCHES 1
#endif
extern "C" void kernel_launch(void* const* d_in, const int* in_sizes, int n_in, void* d_out, int out_size, void* d_ws, size_t ws_size, hipStream_t stream) {
    if (n_in != 22 || out_size != SEQ * DM || ws_size < WS_END) { fprintf(stderr, "kernel_launch: unexpected shapes (n_in %d out %d ws %zu)\n", n_in, out_size, ws_size); return; }
    unsigned char* ws = (unsigned char*)d_ws;
    static int grid = 0;
    if (grid == 0) {
        int dev = 0, cus = 0, per_cu = 0;
        (void)hipGetDevice(&dev); (void)hipDeviceGetAttribute(&cus, hipDeviceAttributeMultiprocessorCount, dev);
        (void)hipFuncSetAttribute((const void*)k_fwd, hipFuncAttributeMaxDynamicSharedMemorySize, LDS_BYTES);
        (void)hipOccupancyMaxActiveBlocksPerMultiprocessor(&per_cu, (const void*)k_fwd, 512, LDS_BYTES);
        if (per_cu < 1) fprintf(stderr, "kernel_launch: occupancy query says %d blocks per CU\n", per_cu);
        (void)hipGetLastError();
        grid = cus > 0 ? cus : 256;
    }
    (void)hipMemsetAsync(ws + WS_CTL, 0, CTL_ZERO_BYTES, stream);
    Args a; memset(&a, 0, sizeof(a)); for (int i = 0; i < 22; ++i) a.in[i] = (const float*)d_in[i]; a.out = (float*)d_out; a.ws = ws;
    if (MK_N_LAUNCHES == 1) { a.ph_lo = 0; a.ph_hi = N_PHASES; a.li = 0; hipLaunchKernelGGL(k_fwd, dim3(grid), dim3(512), LDS_BYTES, stream, a); }
    else for (int k = 0; k < N_PHASES; ++k) { a.ph_lo = k; a.ph_hi = k + 1; a.li = k; hipLaunchKernelGGL(k_fwd, dim3(grid), dim3(512), LDS_BYTES, stream, a); }
}
```

```cpp
#include <hip/hip_runtime.h>
#include <cstdio>
#include <cstdint>
#include <cstring>
namespace pg8 {
#define PG8_LAS __attribute__((address_space(3)))
typedef unsigned short bf16_t;
typedef short bf16x8 __attribute__((ext_vector_type(8)));
typedef float f32x4 __attribute__((ext_vector_type(4)));
typedef unsigned u32x4 __attribute__((ext_vector_type(4)));
typedef int i32x4 __attribute__((ext_vector_type(4)));
constexpr int BM = 256, BK = 64, HALF = 128, HTB = HALF * BK * 2  , STAGE_BYTES = 8 * HTB, NXCD = 8, WGM = 8;

__host__ __device__ __forceinline__ int lds_byte(int r, int c) { const int st = (r >> 4) * 2 + (c >> 5), rr = r & 15, cc = c & 31, ob = rr * 64 + cc * 2; return st * 1024 + (ob ^ (((ob >> 9) & 1) << 5)); }
__host__ __device__ __forceinline__ void stage_rc(int b, int& R, int& C) { const int st = b / 1024, sb = b % 1024, swz = sb ^ (((sb >> 9) & 1) << 5); R = (st >> 1) * 16 + swz / 64; C = (st & 1) * 32 + (swz % 64) / 2; }
__host__ __device__ __forceinline__ int perm32(int rho) { const int n = rho >> 4, i = rho & 15; return 8 * (i >> 2) + 4 * n + (i & 3); }

struct Unit { int pm, pn; };
struct Gemm { const bf16_t* A; const bf16_t* Bt; int M, N, K; size_t a_tstep = 0; };

struct StaticOrder {
    int nM, nN, nwg, G, c;
    __host__ __device__ void init(int M, int N, int G_, int c_) { nM = M / BM; nN = N / BM; nwg = nM * nN; G = G_; c = c_; }
    __host__ __device__ bool next(int i, Unit& u) const {
        const long L = (long)i * G + c; if (L >= nwg) return false;
        int wgid = (int)L; { const int q = nwg / NXCD, r = nwg % NXCD, xcd = wgid % NXCD, off = wgid / NXCD; wgid = (xcd < r ? xcd * (q + 1) : r * (q + 1) + (xcd - r) * q) + off; }
        const int nig = WGM * nN, gid = wgid / nig, fm = gid * WGM, gsz = (nM - fm) < WGM ? (nM - fm) : WGM;
        u.pm = fm + ((wgid % nig) % gsz); u.pn = (wgid % nig) / gsz; return true;
    }
    __device__ __forceinline__ void a_ready(const Unit&) const {}
    __device__ __forceinline__ void done(const Unit&) const {}
};
__device__ __forceinline__ unsigned cvt_pk_bf16(float lo, float hi) { unsigned r; asm volatile("v_cvt_pk_bf16_f32 %0, %1, %2" : "=v"(r) : "v"(lo), "v"(hi)); return r; }
template <class Epi, class Sched, bool ALIGN_EPI = false, bool SP2 = false>
__device__ __forceinline__ void gemm_phase(PG8_LAS unsigned char* lds, const Gemm g, const Sched& S, const Epi& E) {
    const int tid = threadIdx.x, wid = __builtin_amdgcn_readfirstlane(tid >> 6), lane = tid & 63, wr = wid >> 2, wc = wid & 3, fr = lane & 15, fq = lane >> 4;
    const int K = g.K, nt = Epi::I8 ? K / 128 : K / BK;
    unsigned voffA[2], voffB[2];
#pragma unroll
    for (int i = 0; i < 2; ++i) { int R, C; stage_rc(tid * 16 + i * 8192, R, C); const int Rb = Epi::PERM ? ((R & ~31) + perm32(R & 31)) : R;
        const int Ra = Epi::APERM ? ((R & ~63) | (4 * (R & 15) + ((R >> 4) & 3))) : R;
        voffA[i] = Epi::I8 ? (unsigned)(Ra * K + 2 * C) : (unsigned)(Ra * K + C) * 2u; voffB[i] = Epi::I8 ? (unsigned)(Rb * K + 2 * C) : (unsigned)(Rb * K + C) * 2u; }
    const size_t kstep = (size_t)(BK * 2);
    const size_t hstep = (size_t)HALF * K * (Epi::I8 ? 1 : 2);
    const size_t tstep = 2 * hstep;
    const size_t tstepA = g.a_tstep ? g.a_tstep : tstep;
    const unsigned ldsw = (unsigned)wid * 1024u;
    const int aoff = lds_byte(wr * 64 + fr, fq * 8), boff = lds_byte(wc * 32 + fr, fq * 8);
#define PG8_SA(b, h) (((b) * 2 + (h)) * HTB)
#define PG8_SB(b, h) ((4 + (b) * 2 + (h)) * HTB)
#define PG8_STAGE(bufoff, gbase, voff) do { _Pragma("unroll") for (int _i = 0; _i < 2; ++_i) \
        __builtin_amdgcn_global_load_lds((const unsigned*)((const char*)(gbase) + (voff)[_i]), (PG8_LAS unsigned*)(lds + (bufoff) + ldsw + _i * 8192), 16, 0, 0); } while (0)
#define PG8_LDA(dst, b, h) do { _Pragma("unroll") for (int m = 0; m < 4; ++m) _Pragma("unroll") for (int k = 0; k < 2; ++k) dst[m][k] = *(const PG8_LAS bf16x8*)(lds + PG8_SA(b, h) + aoff + m * 2048 + k * 1024); } while (0)
#define PG8_LDB(dst, b, h) do { _Pragma("unroll") for (int n = 0; n < 2; ++n) _Pragma("unroll") for (int k = 0; k < 2; ++k) dst[n][k] = *(const PG8_LAS bf16x8*)(lds + PG8_SB(b, h) + boff + n * 2048 + k * 1024); } while (0)
#define PG8_MMA(ai, bj, At, Bt) do { __builtin_amdgcn_s_setprio(1); _Pragma("unroll") for (int m = 0; m < 4; ++m) _Pragma("unroll") for (int n = 0; n < 2; ++n) _Pragma("unroll") for (int k = 0; k < 2; ++k) \
        { if constexpr (Epi::I8) acc[ai][bj][m][n] = __builtin_bit_cast(f32x4, __builtin_amdgcn_mfma_i32_16x16x64_i8(__builtin_bit_cast(i32x4, Bt[n][k]), __builtin_bit_cast(i32x4, At[m][k]), __builtin_bit_cast(i32x4, acc[ai][bj][m][n]), 0, 0, 0)); \
          else acc[ai][bj][m][n] = __builtin_amdgcn_mfma_f32_16x16x32_bf16(Bt[n][k], At[m][k], acc[ai][bj][m][n], 0, 0, 0); } __builtin_amdgcn_s_setprio(0); } while (0)
#define PG8_WAIT_V(n) asm volatile("s_waitcnt vmcnt(" #n ")" ::: "memory")
#define PG8_WAIT_L(n) asm volatile("s_waitcnt lgkmcnt(" #n ")" ::: "memory")
#define PG8_BAR __builtin_amdgcn_s_barrier()
#define PG8_SCHED __builtin_amdgcn_sched_barrier(0)
    Unit cur, nxt; int ui = 0;
    if (!S.next(0, cur)) return;
    f32x4 acc[2][2][4][2];
#pragma unroll
    for (int a = 0; a < 2; ++a)
#pragma unroll
        for (int b = 0; b < 2; ++b)
#pragma unroll
            for (int m = 0; m < 4; ++m)
#pragma unroll
                for (int n = 0; n < 2; ++n) acc[a][b][m][n] = (f32x4){0.f, 0.f, 0.f, 0.f};
    bf16x8 At[4][2], B0[2][2], B1[2][2];
    const char* cA = (const char*)g.A + (size_t)cur.pm * tstepA; const char* cB = (const char*)g.Bt + (size_t)cur.pn * tstep;
    S.a_ready(cur);
    if constexpr (SP2) {
        PG8_STAGE(PG8_SB(0, 0), cB, voffB); PG8_STAGE(PG8_SB(0, 1), cB + hstep, voffB); PG8_STAGE(PG8_SA(0, 0), cA, voffA); PG8_STAGE(PG8_SA(0, 1), cA + hstep, voffA);
        if (wr == 1) PG8_BAR;
        PG8_WAIT_V(2); PG8_BAR;
        PG8_STAGE(PG8_SB(1, 0), cB + kstep, voffB); PG8_STAGE(PG8_SA(1, 0), cA + kstep, voffA); PG8_STAGE(PG8_SB(1, 1), cB + hstep + kstep, voffB);
        PG8_WAIT_V(6); PG8_BAR;
    } else {
        PG8_STAGE(PG8_SB(0, 0), cB, voffB); PG8_STAGE(PG8_SA(0, 0), cA, voffA); PG8_STAGE(PG8_SB(0, 1), cB + hstep, voffB); PG8_STAGE(PG8_SA(0, 1), cA + hstep, voffA);
        if (wr == 1) PG8_BAR;
        PG8_WAIT_V(4); PG8_BAR;
        PG8_STAGE(PG8_SB(1, 0), cB + kstep, voffB); PG8_STAGE(PG8_SA(1, 0), cA + kstep, voffA); PG8_STAGE(PG8_SB(1, 1), cB + hstep + kstep, voffB);
        PG8_WAIT_V(6); PG8_BAR;
    }
    for (;;) {
        const bool has_next = S.next(ui + 1, nxt);
        const char* nA = has_next ? (const char*)g.A + (size_t)nxt.pm * tstepA : cA; const char* nB = has_next ? (const char*)g.Bt + (size_t)nxt.pn * tstep : cB;
        for (int t = 0; t < nt; t += 2) {
            const bool last = (t == nt - 2);
            const char* a1 = cA + (size_t)(t + 1) * kstep;
            const char* a2 = last ? nA : cA + (size_t)(t + 2) * kstep; const char* b2 = last ? nB : cB + (size_t)(t + 2) * kstep;
            const char* a3 = a2 + kstep; const char* b3 = b2 + kstep;
            if (last && has_next) S.a_ready(nxt);
            if constexpr (Epi::HAS_MID) { if (t == E.tmid) E.mid(acc, cur, wr, fr); }
            if constexpr (SP2) {
            PG8_LDB(B0, 0, 0); PG8_LDB(B1, 0, 1); PG8_SCHED; PG8_LDA(At, 0, 0); PG8_STAGE(PG8_SA(1, 1), a1 + hstep, voffA);
            PG8_WAIT_V(8); PG8_WAIT_L(0); PG8_BAR; PG8_MMA(0, 0, At, B0); PG8_MMA(0, 1, At, B1); PG8_BAR; PG8_SCHED;
            PG8_LDA(At, 0, 1); PG8_STAGE(PG8_SB(0, 0), b2, voffB); PG8_STAGE(PG8_SB(0, 1), b2 + hstep, voffB); PG8_STAGE(PG8_SA(0, 0), a2, voffA);
            PG8_WAIT_V(8); PG8_WAIT_L(0); PG8_BAR; PG8_MMA(1, 0, At, B0); PG8_MMA(1, 1, At, B1); PG8_BAR; PG8_SCHED;
            PG8_LDB(B0, 1, 0); PG8_LDB(B1, 1, 1); PG8_SCHED; PG8_LDA(At, 1, 0); PG8_STAGE(PG8_SA(0, 1), a2 + hstep, voffA);
            PG8_WAIT_V(8); PG8_WAIT_L(0); PG8_BAR; PG8_MMA(0, 0, At, B0); PG8_MMA(0, 1, At, B1); PG8_BAR; PG8_SCHED;
            PG8_LDA(At, 1, 1); PG8_STAGE(PG8_SB(1, 0), b3, voffB); PG8_STAGE(PG8_SB(1, 1), b3 + hstep, voffB); PG8_STAGE(PG8_SA(1, 0), a3, voffA);
            PG8_WAIT_V(8); PG8_WAIT_L(0); PG8_BAR; PG8_MMA(1, 0, At, B0); PG8_MMA(1, 1, At, B1); PG8_BAR; PG8_SCHED;
            } else {
            PG8_LDB(B0, 0, 0); PG8_SCHED; PG8_LDA(At, 0, 0); PG8_STAGE(PG8_SA(1, 1), a1 + hstep, voffA);
            PG8_WAIT_L(8); PG8_BAR; PG8_WAIT_L(0); PG8_MMA(0, 0, At, B0); PG8_BAR; PG8_SCHED;
            PG8_LDB(B1, 0, 1); PG8_STAGE(PG8_SB(0, 0), b2, voffB);
            PG8_BAR; PG8_WAIT_L(0); PG8_MMA(0, 1, At, B1); PG8_BAR;
            PG8_LDA(At, 0, 1); PG8_STAGE(PG8_SA(0, 0), a2, voffA);
            PG8_BAR; PG8_WAIT_L(0); PG8_MMA(1, 0, At, B0); PG8_BAR; PG8_SCHED;
            PG8_STAGE(PG8_SB(0, 1), b2 + hstep, voffB);
            PG8_WAIT_V(6); PG8_BAR; PG8_MMA(1, 1, At, B1); PG8_BAR;
            PG8_LDB(B0, 1, 0); PG8_SCHED; PG8_LDA(At, 1, 0); PG8_STAGE(PG8_SA(0, 1), a2 + hstep, voffA);
            PG8_WAIT_L(8); PG8_BAR; PG8_WAIT_L(0); PG8_MMA(0, 0, At, B0); PG8_BAR; PG8_SCHED;
            PG8_LDB(B1, 1, 1); PG8_STAGE(PG8_SB(1, 0), b3, voffB);
            PG8_BAR; PG8_WAIT_L(0); PG8_MMA(0, 1, At, B1); PG8_BAR;
            PG8_LDA(At, 1, 1); PG8_STAGE(PG8_SA(1, 0), a3, voffA);
            PG8_BAR; PG8_WAIT_L(0); PG8_MMA(1, 0, At, B0); PG8_BAR; PG8_SCHED;
            PG8_STAGE(PG8_SB(1, 1), b3 + hstep, voffB);
            PG8_WAIT_V(6); PG8_BAR; PG8_MMA(1, 1, At, B1); PG8_BAR;
            }
        }
        if constexpr (ALIGN_EPI) { if (wr == 0) PG8_BAR; }
        if constexpr (!Epi::AFTER_DRAIN) { E(acc, cur, wr, wc, fr, fq); S.done(cur); }
        if (!has_next) break;
#pragma unroll
        for (int a = 0; a < 2; ++a)
#pragma unroll
            for (int b = 0; b < 2; ++b)
#pragma unroll
                for (int m = 0; m < 4; ++m)
#pragma unroll
                    for (int n = 0; n < 2; ++n) acc[a][b][m][n] = (f32x4){0.f, 0.f, 0.f, 0.f};
        cur = nxt; cA = nA; cB = nB; ++ui;
        if constexpr (ALIGN_EPI) { if (wr == 1) PG8_BAR; }
    }
    PG8_WAIT_V(0);
    if constexpr (!ALIGN_EPI) { if (wr == 0) PG8_BAR; }
    PG8_BAR;
    if constexpr (Epi::AFTER_DRAIN) { E.fused(acc, cur, wr, wc, fr, fq, lds, wid, lane); S.done(cur); }
#undef PG8_SA
#undef PG8_SB
#undef PG8_STAGE
#undef PG8_LDA
#undef PG8_LDB
#undef PG8_MMA
#undef PG8_WAIT_V
#undef PG8_WAIT_L
#undef PG8_BAR
#undef PG8_SCHED
}
}

constexpr int SEQ = 16384, DM = 4096;
constexpr int NQH = 32, NKVH = 4, HD = 64;
constexpr int DSSM = 2048, NSH = 32, SSTATE = 128, SGRP = 8;
constexpr int XBCC = 4096, NPROJ = 8736, NPROJ_PAD = 8960;
constexpr int DFF = 11008, PLE = 256;
constexpr float EPS = 1e-6f;

typedef unsigned short bf16_t;
using pg8::f32x4; using pg8::u32x4; using pg8::cvt_pk_bf16;
typedef unsigned u32x2 __attribute__((ext_vector_type(2)));
#define LAS __attribute__((address_space(3)))

__device__ __forceinline__ float bf2f(unsigned b) { return __uint_as_float(b << 16); }
__device__ __forceinline__ u32x4 pack8(const f32x4 a, const f32x4 b) { u32x4 w; w.x = cvt_pk_bf16(a[0], a[1]); w.y = cvt_pk_bf16(a[2], a[3]); w.z = cvt_pk_bf16(b[0], b[1]); w.w = cvt_pk_bf16(b[2], b[3]); return w; }
__device__ __forceinline__ u32x2 pack4(const f32x4 a) { u32x2 w; w.x = cvt_pk_bf16(a[0], a[1]); w.y = cvt_pk_bf16(a[2], a[3]); return w; }
__device__ __forceinline__ void unpack8(const u32x4 w, float (&o)[8]) {
    o[0] = bf2f(w.x & 0xffffu); o[1] = __uint_as_float(w.x & 0xffff0000u); o[2] = bf2f(w.y & 0xffffu); o[3] = __uint_as_float(w.y & 0xffff0000u);
    o[4] = bf2f(w.z & 0xffffu); o[5] = __uint_as_float(w.z & 0xffff0000u); o[6] = bf2f(w.w & 0xffffu); o[7] = __uint_as_float(w.w & 0xffff0000u); }
__device__ __forceinline__ float silu_f(float x) { return x * __builtin_amdgcn_rcpf(1.f + __expf(-x)); }
__device__ __forceinline__ float sigm_f(float x) { return __builtin_amdgcn_rcpf(1.f + __expf(-x)); }
__device__ __forceinline__ float softplus_f(float x) { return x > 20.f ? x : log1pf(expf(x)); }
__device__ __forceinline__ float wave_sum(float v) {
#pragma unroll
    for (int o = 1; o < 64; o <<= 1) v += __shfl_xor(v, o);
    return v;
}

constexpr size_t MiB = 1u << 20;
constexpr size_t WS_CTL = 0, CTL_ZERO_BYTES = 1 * MiB;
constexpr size_t WS_RS0 = 1 * MiB;
constexpr size_t WS_COS = 2 * MiB, WS_SIN = 4 * MiB;
constexpr size_t WS_DT = 6 * MiB;
constexpr size_t WS_WIN = 8 * MiB;
constexpr size_t WS_WO = 78 * MiB;
constexpr size_t WS_WUP = 110 * MiB;
constexpr size_t WS_WDN = 282 * MiB;
constexpr size_t WS_WG = 368 * MiB;
constexpr size_t WS_WP = 400 * MiB;
constexpr size_t WS_PB = 402 * MiB;
constexpr size_t WS_XB = 410 * MiB;
constexpr size_t WS_MIX = 538 * MiB;
constexpr size_t WS_Y = 666 * MiB;
constexpr size_t WS_PP = 1226 * MiB;
constexpr size_t WS_U = 538 * MiB;
constexpr size_t WS_Q = 794 * MiB;
constexpr size_t WS_K = 858 * MiB;
constexpr size_t WS_V = 866 * MiB;
constexpr size_t WS_Z = 874 * MiB;
constexpr size_t WS_XBC = 938 * MiB;
constexpr size_t WS_XACT = 1066 * MiB;
constexpr size_t WS_ACT = 882 * MiB;
constexpr size_t WS_H1Q = WS_Y, WS_H2Q = WS_MIX;
constexpr size_t WS_END = 1354 * MiB;
constexpr int CW_BAR = 4096;
constexpr int CW_CMAX_UP = 131072, CW_CMAX_G = 131072 + 22016;
constexpr float QCLIP = 4.5f;
constexpr int CW_RSS_SSM = 65536, CW_RSS1 = 65536 + 16384, CW_RSS3 = 65536 + 32768;

#define XB_TMO      128
#define XB_XCNT(j)  (256  + 64 * (j))
#define XB_XSUB(j)  (1280 + 64 * (j))
#define XB_XGEN(j)  (2304 + 64 * (j))
#define XB_TOP      3328
#define XB_TOPGEN   3392
#define XCD_BAR_WORDS 3456
#define XB_SPIN_CAP (1u << 18)

__device__ __forceinline__ unsigned xb_ld(unsigned* p)              { return __hip_atomic_load(p, __ATOMIC_RELAXED, __HIP_MEMORY_SCOPE_AGENT); }
__device__ __forceinline__ unsigned xb_add(unsigned* p, unsigned v) { return __hip_atomic_fetch_add(p, v, __ATOMIC_RELAXED, __HIP_MEMORY_SCOPE_AGENT); }
__device__ __forceinline__ unsigned xb_xcc_id() { return (unsigned)__builtin_amdgcn_s_getreg((3 << 11) | 20) & 0xFu; }
#define XB_SPIN(cond, bar) do { unsigned _sp = 0; while (cond) { __builtin_amdgcn_s_sleep(1); \
    if ((++_sp & 255u) == 0u) { if (xb_ld(&(bar)[XB_TMO])) break; if (_sp > XB_SPIN_CAP) { atomicAdd(&(bar)[XB_TMO], 1u); break; } } } } while (0)

struct XcdBarrier {
    unsigned* bar; unsigned x;
    volatile LAS unsigned* st;
};

__device__ __forceinline__ XcdBarrier xcd_barrier_post(unsigned* bar, volatile LAS unsigned* st) {
    XcdBarrier b; b.bar = bar; b.x = xb_xcc_id(); b.st = st;
    if (threadIdx.x == 0) (void)xb_add(&bar[XB_XCNT(b.x)], 1u);
    return b;
}
__device__ __forceinline__ void xcd_barrier_complete(unsigned* bar, unsigned x, unsigned& nloc, unsigned& nx) {
    const unsigned G = gridDim.x * gridDim.y * gridDim.z;
    unsigned sum, cnt, mine, sp = 0u;
    for (;;) {
        sum = 0u; cnt = 0u; mine = 0u;
#pragma unroll
        for (unsigned j = 0; j < 16; ++j) { const unsigned c = xb_ld(&bar[XB_XCNT(j)]); sum += c; cnt += (c > 0u) ? 1u : 0u; mine = (j == x) ? c : mine; }
        if (sum == G) break;
        __builtin_amdgcn_s_sleep(1);
        if ((++sp & 255u) == 0u) { if (xb_ld(&bar[XB_TMO])) break; if (sp > XB_SPIN_CAP) { atomicAdd(&bar[XB_TMO], 1u); break; } }
    }
    nloc = mine > 0u ? mine : 1u; nx = cnt > 0u ? cnt : 1u;
}

__device__ __forceinline__ void xcd_barrier(const XcdBarrier& b) {
    asm volatile("s_waitcnt vmcnt(0)" ::: "memory");
    __syncthreads();
    if (threadIdx.x == 0) {
        unsigned* bar = b.bar;
        __builtin_amdgcn_s_waitcnt(0);
        unsigned nloc = b.st[0], nx = b.st[1];
        if (nloc == 0u) { xcd_barrier_complete(bar, b.x, nloc, nx); b.st[0] = nloc; b.st[1] = nx; }
        const unsigned old = xb_add(&bar[XB_XSUB(b.x)], 1u);
        const unsigned gen = old / nloc;
        if (old + 1u == (gen + 1u) * nloc) {
            __builtin_amdgcn_fence(__ATOMIC_RELEASE, "agent");
            asm volatile("s_waitcnt vmcnt(0)" ::: "memory");
            const unsigned og = xb_add(&bar[XB_TOP], 1u);
            const unsigned tg = og / nx;
            if (og + 1u == (tg + 1u) * nx) xb_add(&bar[XB_TOPGEN], 1u);
            else XB_SPIN(xb_ld(&bar[XB_TOPGEN]) == tg, bar);
            __builtin_amdgcn_fence(__ATOMIC_ACQUIRE, "agent");
            xb_add(&bar[XB_XGEN(b.x)], 1u);
            asm volatile("s_waitcnt vmcnt(0)" ::: "memory");
        } else {
            XB_SPIN(xb_ld(&bar[XB_XGEN(b.x)]) == gen, bar);
            __builtin_amdgcn_fence(__ATOMIC_ACQUIRE, "agent");
            asm volatile("s_waitcnt vmcnt(0)" ::: "memory");
        }
    }
    __syncthreads();
}
__device__ __forceinline__ int cperm(int p) { return (p & 0xE0) | (((p >> 2) & 3) << 3) | (((p >> 4) & 1) << 2) | (p & 3); }
__device__ __forceinline__ int colmap(int kind, int row) {
    const int tile = row >> 8, p = row & 255;
    if (kind == 0) return (tile << 8) | cperm(p);
    if (kind == 1) {
        if (tile < 9) { const int bj = p >> 7, wc = (p >> 5) & 3, n = (p >> 4) & 1, fq = (p >> 2) & 3, j = p & 3;
            return tile * 256 + (2 * bj + (wc >> 1)) * 64 + 32 * n + 16 * (wc & 1) + 4 * fq + j; }
        if (tile < 34) return (tile << 8) | cperm(p);
        const int c = cperm(p); return c < 32 ? 8704 + c : -1;
    }
    { const int bj = p >> 7, cc = cperm(p) & 127; return bj * DFF + tile * 128 + cc; }
}
__device__ __forceinline__ int srcbase_of(int kind, int r0) {
    if (kind == 2) { const int pn = r0 >> 8, q64 = (r0 >> 6) & 3; return (q64 >> 1) * DFF + pn * 128 + (q64 & 1) * 64; }
    return r0;
}
struct TrJob { const float* W; bf16_t* WT; const float* kscale; const float* qmax; int K, N, nrows, kind, kxor, kscale_n, pad; };
__device__ __forceinline__ void ph_transpose(const TrJob job, LAS unsigned* scr, int gw, int NGW, int lane) {
    const float* __restrict__ W = job.W; bf16_t* __restrict__ WT = job.WT; const float* __restrict__ ks = job.kscale;
    const int ngrp = job.nrows / 64, nitems = (job.K / 64) * ngrp;
    for (int item = gw; item < nitems; item += NGW) {
        const int kb = item / ngrp, gq = item % ngrp, k0 = 64 * kb, r0 = 64 * gq, sb = srcbase_of(job.kind, r0);
        const int n4 = (lane & 15) * 4; const bool inb = sb + n4 < job.N;
        f32x4 v[8][2];
#pragma unroll
        for (int i = 0; i < 8; ++i) { const int kp = 4 * i + (lane >> 4);
#pragma unroll
            for (int q = 0; q < 2; ++q) { const int k = k0 + 2 * kp + q; f32x4 t = {0.f, 0.f, 0.f, 0.f};
                if (inb) t = *(const f32x4*)(W + (size_t)(k ^ job.kxor) * job.N + sb + n4);
                v[i][q] = t; } }
        asm volatile("" ::: "memory");
        if (ks) { float kv[8][2];
#pragma unroll
            for (int i = 0; i < 8; ++i) { const int kp = 4 * i + (lane >> 4);
#pragma unroll
                for (int q = 0; q < 2; ++q) { const int k = k0 + 2 * kp + q; kv[i][q] = k < job.kscale_n ? ks[k] : 1.f; } }
#pragma unroll
            for (int i = 0; i < 8; ++i)
#pragma unroll
                for (int q = 0; q < 2; ++q) v[i][q] = v[i][q] * kv[i][q]; }
#pragma unroll
        for (int i = 0; i < 8; ++i) { const int kp = 4 * i + (lane >> 4);
#pragma unroll
            for (int e = 0; e < 4; ++e) scr[kp * 65 + n4 + e] = cvt_pk_bf16(v[i][0][e], v[i][1][e]); }
        asm volatile("s_waitcnt lgkmcnt(0)" ::: "memory");
        const int c = lane & 7;
#pragma unroll
        for (int j = 0; j < 8; ++j) { const int n = (lane >> 3) + 8 * j; const int sc = colmap(job.kind, r0 + n) - sb;
            u32x4 o = {0u, 0u, 0u, 0u};
            if (sc >= 0) { o.x = scr[(4 * c + 0) * 65 + sc]; o.y = scr[(4 * c + 1) * 65 + sc]; o.z = scr[(4 * c + 2) * 65 + sc]; o.w = scr[(4 * c + 3) * 65 + sc]; }
            *(u32x4*)(WT + (size_t)(r0 + n) * job.K + k0 + 8 * c) = o; }
        asm volatile("s_waitcnt lgkmcnt(0)" ::: "memory");
    }
}
__device__ __forceinline__ void ph_xprep(const float* __restrict__ x, bf16_t* __restrict__ xb, float* __restrict__ rs0, int gw, int NGW, int lane) {
    for (int t = gw; t < SEQ; t += NGW) {
        const f32x4* xr = (const f32x4*)(x + (size_t)t * DM); f32x4 a[8], b[8]; float ss = 0.f;
#pragma unroll
        for (int i = 0; i < 8; ++i) { a[i] = xr[(i * 64 + lane) * 2]; b[i] = xr[(i * 64 + lane) * 2 + 1]; }
#pragma unroll
        for (int i = 0; i < 8; ++i) { ss += (a[i][0] * a[i][0] + a[i][1] * a[i][1]) + (a[i][2] * a[i][2] + a[i][3] * a[i][3]) + (b[i][0] * b[i][0] + b[i][1] * b[i][1]) + (b[i][2] * b[i][2] + b[i][3] * b[i][3]);
            *(u32x4*)(xb + (size_t)t * DM + (i * 64 + lane) * 8) = pack8(a[i], b[i]); }
        ss = wave_sum(ss);
        if (lane == 0) rs0[t] = rsqrtf(ss * (1.f / DM) + EPS);
    }
}
__device__ __forceinline__ void ph_pprep(const float* __restrict__ p, bf16_t* __restrict__ pb, size_t gt, size_t NGT) {
    const size_t n8 = (size_t)SEQ * PLE / 8;
    for (size_t i = gt; i < n8; i += NGT) {
        const f32x4 a = ((const f32x4*)p)[2 * i], b = ((const f32x4*)p)[2 * i + 1]; ((u32x4*)pb)[i] = pack8(a, b); }
}
__device__ __forceinline__ void ph_trig(const int* __restrict__ positions, float* __restrict__ cosT, float* __restrict__ sinT, size_t gt, size_t NGT) {
  for (size_t ii = gt; ii < (size_t)SEQ * 32; ii += NGT) { const int i = (int)ii;
    const int t = i >> 5, f = i & 31;
    const float invf = powf(10000.f, -(float)f / 32.f);
    const float ang = (float)positions[t] * invf;
    float s, c; sincosf(ang, &s, &c); cosT[i] = c; sinT[i] = s; }
}
__device__ __forceinline__ void ph_convglu(const bf16_t* __restrict__ U, const float* __restrict__ cw, const float* __restrict__ cb, bf16_t* __restrict__ ACT, int half, size_t gt, size_t NGT) {
    const size_t nitems = (size_t)688 * (SEQ / 16);
    for (size_t it = gt; it < nitems; it += NGT) {
        const int cgi = (int)(it % 688), seg = (int)(it / 688), pl = cgi >> 4, cc = (cgi & 15) * 8, c0 = (half * 43 + pl) * 128 + cc, t0 = seg * 16;
        float wg[3][8], wu[3][8], bg[8], bu[8];
#pragma unroll
        for (int k = 0; k < 3; ++k) { const f32x4 g0 = *(const f32x4*)(cw + (size_t)k * 2 * DFF + c0), g1 = *(const f32x4*)(cw + (size_t)k * 2 * DFF + c0 + 4), u0 = *(const f32x4*)(cw + (size_t)k * 2 * DFF + DFF + c0), u1 = *(const f32x4*)(cw + (size_t)k * 2 * DFF + DFF + c0 + 4);
#pragma unroll
            for (int e = 0; e < 4; ++e) { wg[k][e] = g0[e]; wg[k][4 + e] = g1[e]; wu[k][e] = u0[e]; wu[k][4 + e] = u1[e]; } }
        { const f32x4 g0 = *(const f32x4*)(cb + c0), g1 = *(const f32x4*)(cb + c0 + 4), u0 = *(const f32x4*)(cb + DFF + c0), u1 = *(const f32x4*)(cb + DFF + c0 + 4);
#pragma unroll
          for (int e = 0; e < 4; ++e) { bg[e] = g0[e]; bg[4 + e] = g1[e]; bu[e] = u0[e]; bu[4 + e] = u1[e]; } }
        u32x4 rg[18], ru[18];
#pragma unroll
        for (int i = 0; i < 18; ++i) { const int tt = t0 - 2 + i;
            if (tt >= 0) { rg[i] = *(const u32x4*)(U + (size_t)tt * DFF + pl * 256 + cc); ru[i] = *(const u32x4*)(U + (size_t)tt * DFF + pl * 256 + 128 + cc); }
            else { rg[i] = (u32x4){0u, 0u, 0u, 0u}; ru[i] = (u32x4){0u, 0u, 0u, 0u}; } }
        float g2[8], g1v[8], u2[8], u1v[8];
        unpack8(rg[0], g2); unpack8(rg[1], g1v); unpack8(ru[0], u2); unpack8(ru[1], u1v);
#pragma unroll
        for (int i = 0; i < 16; ++i) { float gv[8], uv[8]; unpack8(rg[i + 2], gv); unpack8(ru[i + 2], uv); float o[8];
#pragma unroll
            for (int e = 0; e < 8; ++e) { const float g = bg[e] + wg[0][e] * g2[e] + wg[1][e] * g1v[e] + wg[2][e] * gv[e], u = bu[e] + wu[0][e] * u2[e] + wu[1][e] * u1v[e] + wu[2][e] * uv[e];
                o[e] = silu_f(g) * u; g2[e] = g1v[e]; g1v[e] = gv[e]; u2[e] = u1v[e]; u1v[e] = uv[e]; }
            u32x4 w; w.x = cvt_pk_bf16(o[0], o[1]); w.y = cvt_pk_bf16(o[2], o[3]); w.z = cvt_pk_bf16(o[4], o[5]); w.w = cvt_pk_bf16(o[6], o[7]);
            *(u32x4*)(ACT + (size_t)(t0 + i) * DFF + c0) = w; }
    }
}
__device__ __forceinline__ void ph_final_norm(float* H, const float* __restrict__ rowss, const float* __restrict__ g, size_t gt, size_t NGT) {
    const size_t n4 = (size_t)SEQ * DM / 4;
    f32x4* h4 = (f32x4*)H;
    for (size_t i0 = gt; i0 < n4; i0 += 8 * NGT) {
        f32x4 v[8]; float rs[8];
#pragma unroll
        for (int k = 0; k < 8; ++k) { const size_t i = i0 + k * NGT; v[k] = h4[i]; rs[k] = rowss[i >> 10]; }
#pragma unroll
        for (int k = 0; k < 8; ++k) { const size_t i = i0 + k * NGT; const f32x4 gg = ((const f32x4*)g)[i & 1023]; h4[i] = v[k] * rsqrtf(rs[k] * (1.f / DM) + EPS) * gg; }
    }
}

constexpr float CMAX_SAFE = 1.1f;
__device__ __forceinline__ void ph_colmax(const float* __restrict__ W, const float* __restrict__ g, int K, int N, unsigned* cmax, int gw, int NGW, int lane) {
    const int ncb = N / 256, nitems = (K / 64) * ncb;
    for (int item = gw; item < nitems; item += NGW) { const int kb = item / ncb, cb = item % ncb, col = cb * 256 + lane * 4;
        f32x4 m = {0.f, 0.f, 0.f, 0.f};
        f32x4 v[16];
#pragma unroll
        for (int kk = 0; kk < 16; ++kk) v[kk] = *(const f32x4*)(W + (size_t)(kb * 64 + 4 * kk) * N + col);
#pragma unroll
        for (int kk = 0; kk < 16; ++kk) { const float gg = g ? g[kb * 64 + 4 * kk] : 1.f;
#pragma unroll
            for (int e = 0; e < 4; ++e) m[e] = fmaxf(m[e], fabsf(v[kk][e] * gg)); }
#pragma unroll
        for (int e = 0; e < 4; ++e) atomicMax(cmax + col + e, __float_as_uint(m[e] * CMAX_SAFE)); }
}

__device__ __forceinline__ void ph_transpose_q8(const TrJob job, LAS unsigned* scr, int gw, int NGW, int lane) {
    const float* __restrict__ W = job.W; signed char* __restrict__ WQ = (signed char*)job.WT; const float* __restrict__ ks = job.kscale;
    const int ngrp = job.nrows / 64, nitems = (job.K / 64) * ngrp;
    for (int item = gw; item < nitems; item += NGW) {
        const int kb = item / ngrp, gq = item % ngrp, k0 = 64 * kb, r0 = 64 * gq, sb = srcbase_of(job.kind, r0);
        const int n4 = (lane & 15) * 4; const bool inb = sb + n4 < job.N;
        f32x4 isc = {0.f, 0.f, 0.f, 0.f};
        if (inb) { const f32x4 cm = *(const f32x4*)(job.qmax + sb + n4);
#pragma unroll
            for (int e = 0; e < 4; ++e) isc[e] = cm[e] > 0.f ? 127.f / cm[e] : 0.f; }
        f32x4 v[4][4];
#pragma unroll
        for (int i = 0; i < 4; ++i) { const int kq = 4 * i + (lane >> 4);
#pragma unroll
            for (int q = 0; q < 4; ++q) { const int k = k0 + 4 * kq + q; f32x4 t = {0.f, 0.f, 0.f, 0.f};
                if (inb) t = *(const f32x4*)(W + (size_t)k * job.N + sb + n4);
                v[i][q] = t; } }
        asm volatile("" ::: "memory");
        { float kv[4][4];
#pragma unroll
          for (int i = 0; i < 4; ++i) { const int kq = 4 * i + (lane >> 4);
#pragma unroll
              for (int q = 0; q < 4; ++q) { const int k = k0 + 4 * kq + q; kv[i][q] = (ks && k < job.kscale_n) ? ks[k] : 1.f; } }
#pragma unroll
          for (int i = 0; i < 4; ++i)
#pragma unroll
              for (int q = 0; q < 4; ++q) v[i][q] = v[i][q] * isc * kv[i][q]; }
#pragma unroll
        for (int i = 0; i < 4; ++i) { const int kq = 4 * i + (lane >> 4);
#pragma unroll
            for (int e = 0; e < 4; ++e) { const int b0 = (int)rintf(fminf(fmaxf(v[i][0][e], -127.f), 127.f)), b1 = (int)rintf(fminf(fmaxf(v[i][1][e], -127.f), 127.f)), b2 = (int)rintf(fminf(fmaxf(v[i][2][e], -127.f), 127.f)), b3 = (int)rintf(fminf(fmaxf(v[i][3][e], -127.f), 127.f));
                scr[kq * 65 + n4 + e] = (unsigned)(b0 & 255) | ((unsigned)(b1 & 255) << 8) | ((unsigned)(b2 & 255) << 16) | ((unsigned)b3 << 24); } }
        asm volatile("s_waitcnt lgkmcnt(0)" ::: "memory");
        const int c = lane & 3;
#pragma unroll
        for (int j = 0; j < 4; ++j) { const int n = (lane >> 2) + 16 * j; const int sc = colmap(job.kind, r0 + n) - sb;
            u32x4 o = {0u, 0u, 0u, 0u};
            if (sc >= 0) { o.x = scr[(4 * c + 0) * 65 + sc]; o.y = scr[(4 * c + 1) * 65 + sc]; o.z = scr[(4 * c + 2) * 65 + sc]; o.w = scr[(4 * c + 3) * 65 + sc]; }
            *(u32x4*)(WQ + (size_t)(r0 + n) * job.K + k0 + 16 * c) = o; }
        asm volatile("s_waitcnt lgkmcnt(0)" ::: "memory");
    }
}
typedef float f32x16 __attribute__((ext_vector_type(16)));
typedef short bf16x8 __attribute__((ext_vector_type(8)));
typedef short s16x4 __attribute__((ext_vector_type(4)));
#define MFMA32(a, b, c) __builtin_amdgcn_mfma_f32_32x32x16_bf16((a), (b), (c), 0, 0, 0)
constexpr int SSD_XT = 0, SSD_BT = 65536, SSD_CT = 98304, SSD_DT = 132096, SSD_ACS = SSD_DT + 2048;
constexpr size_t WS_STATES = WS_Y, WS_PREV = WS_XACT, WS_CDEC = WS_RS0 + 65536;

__device__ __forceinline__ unsigned off_b(unsigned row, unsigned ch) { return 256u * row + 16u * (ch ^ (((row & 3) << 2) | ((row >> 2) & 3))); }
__device__ __forceinline__ bf16x8 lds_row8(LAS const unsigned char* tile, unsigned row, unsigned ch) { return *(LAS const bf16x8*)(tile + off_b(row, ch)); }
__device__ __forceinline__ s16x4 lds_tr4(LAS const unsigned char* tile, unsigned rowbase, unsigned c32, unsigned lane) {
    const unsigned blk = (lane >> 4) & 1, q = (lane & 15) >> 2, p = lane & 3;
    LAS const unsigned char* a = tile + off_b(rowbase + q, 4 * c32 + 2 * blk + (p >> 1)) + 8 * (p & 1);
    return __builtin_bit_cast(s16x4, __builtin_amdgcn_ds_read_tr16_b64_v4i16((LAS s16x4*)a));
}
__device__ __forceinline__ bf16x8 cat4(const s16x4 a, const s16x4 b) { return __builtin_shufflevector(a, b, 0, 1, 2, 3, 4, 5, 6, 7); }
__device__ __forceinline__ float bfs2f(short s) { return __uint_as_float(((unsigned)(unsigned short)s) << 16); }

template <bool NEED_C>
__device__ __forceinline__ void ssd_stage(LAS unsigned char* lds, const bf16_t* XBC, const float* cw, const float* cb, const float* DT, const float* a_log, int c, int g, int tid, int lane, int wave) {
    {
        const int cgi = tid & 63, seg = tid >> 6;
        int col, tch; LAS unsigned char* tile;
        if (cgi < 32) { col = g * 256 + cgi * 8; tile = lds + SSD_XT + (cgi >> 4) * 32768; tch = cgi & 15; }
        else if (cgi < 48) { col = 2048 + g * 128 + (cgi - 32) * 8; tile = lds + SSD_BT; tch = cgi - 32; }
        else { col = 3072 + g * 128 + (cgi - 48) * 8; tile = lds + SSD_CT; tch = cgi - 48; }
        if (NEED_C || cgi < 48) {
            float w[4][8], b[8], xw[3][8];
#pragma unroll
            for (int k = 0; k < 4; ++k) { const f32x4 w0 = *(const f32x4*)(cw + k * XBCC + col), w1 = *(const f32x4*)(cw + k * XBCC + col + 4);
#pragma unroll
                for (int e = 0; e < 4; ++e) { w[k][e] = w0[e]; w[k][4 + e] = w1[e]; } }
            { const f32x4 b0 = *(const f32x4*)(cb + col), b1 = *(const f32x4*)(cb + col + 4);
#pragma unroll
              for (int e = 0; e < 4; ++e) { b[e] = b0[e]; b[4 + e] = b1[e]; } }
            const int t0 = c * 128 + seg * 16;
            u32x4 raw[19];
#pragma unroll
            for (int k = 0; k < 19; ++k) { const int tt = t0 - 3 + k;
                if (k >= 3 || tt >= 0) raw[k] = *(const u32x4*)(XBC + (size_t)tt * XBCC + col);
                else raw[k] = (u32x4){0u, 0u, 0u, 0u}; }
            asm volatile("" ::: "memory");
#pragma unroll
            for (int k = 0; k < 3; ++k) unpack8(raw[k], xw[k]);
#pragma unroll
            for (int i = 0; i < 16; ++i) { float xv[8]; unpack8(raw[3 + i], xv);
                float o[8];
#pragma unroll
                for (int e = 0; e < 8; ++e) { o[e] = silu_f(b[e] + w[0][e] * xw[0][e] + w[1][e] * xw[1][e] + w[2][e] * xw[2][e] + w[3][e] * xv[e]); xw[0][e] = xw[1][e]; xw[1][e] = xw[2][e]; xw[2][e] = xv[e]; }
                u32x4 pk; pk.x = cvt_pk_bf16(o[0], o[1]); pk.y = cvt_pk_bf16(o[2], o[3]); pk.z = cvt_pk_bf16(o[4], o[5]); pk.w = cvt_pk_bf16(o[6], o[7]);
                *(LAS u32x4*)(tile + off_b(seg * 16 + i, tch)) = pk; }
        }
    }
    { const int l = tid >> 2, r = tid & 3, hd = 4 * g + r; const float dtv = DT[(size_t)(c * 128 + l) * 32 + hd]; const float a = -expf(a_log[hd]);
      ((LAS float*)(lds + SSD_DT))[r * 128 + l] = dtv; ((LAS float*)(lds + SSD_ACS))[r * 128 + l] = dtv * a; }
    __syncthreads();
    if (wave < 4) { LAS float* ac = (LAS float*)(lds + SSD_ACS) + wave * 128; const float v0 = ac[2 * lane], v1 = ac[2 * lane + 1]; const float s = v0 + v1; float inc = s;
#pragma unroll
        for (int o = 1; o < 64; o <<= 1) { const float t = __shfl_up(inc, o); if (lane >= o) inc += t; }
        ac[2 * lane] = inc - s + v0; ac[2 * lane + 1] = inc; }
    __syncthreads();
}

__device__ __forceinline__ void ssd_pass1_unit(LAS unsigned char* lds, float* STATES, float* CDEC, int c, int g, int lane, int wave) {
    const int r = wave >> 1, nh = wave & 1, h = lane >> 5, hd = 4 * g + r;
    LAS const unsigned char* xt = lds + SSD_XT + (r >> 1) * 32768; const unsigned xc = 2 * (r & 1);
    LAS const unsigned char* bt = lds + SSD_BT;
    LAS const float* dtl = (LAS const float*)(lds + SSD_DT) + r * 128; LAS const float* acs = (LAS const float*)(lds + SSD_ACS) + r * 128;
    const float alast = acs[127];
    f32x16 acc[2][2];
#pragma unroll
    for (int i = 0; i < 2; ++i)
#pragma unroll
        for (int j = 0; j < 2; ++j)
#pragma unroll
            for (int e = 0; e < 16; ++e) acc[i][j][e] = 0.f;
#pragma unroll
    for (int ks = 0; ks < 8; ++ks) {
        const int lb = 16 * ks + 8 * h;
        const f32x4 d0 = *(LAS const f32x4*)(dtl + lb), d1 = *(LAS const f32x4*)(dtl + lb + 4), a0 = *(LAS const f32x4*)(acs + lb), a1 = *(LAS const f32x4*)(acs + lb + 4);
        float wg[8];
#pragma unroll
        for (int e = 0; e < 4; ++e) { wg[e] = d0[e] * __expf(alast - a0[e]); wg[4 + e] = d1[e] * __expf(alast - a1[e]); }
        bf16x8 A[2], B[2];
#pragma unroll
        for (int pt = 0; pt < 2; ++pt) A[pt] = cat4(lds_tr4(xt, lb, xc + pt, lane), lds_tr4(xt, lb + 4, xc + pt, lane));
#pragma unroll
        for (int nt = 0; nt < 2; ++nt) { const s16x4 t0 = lds_tr4(bt, lb, 2 * nh + nt, lane), t1 = lds_tr4(bt, lb + 4, 2 * nh + nt, lane);
            u32x4 pk; pk.x = cvt_pk_bf16(bfs2f(t0[0]) * wg[0], bfs2f(t0[1]) * wg[1]); pk.y = cvt_pk_bf16(bfs2f(t0[2]) * wg[2], bfs2f(t0[3]) * wg[3]);
            pk.z = cvt_pk_bf16(bfs2f(t1[0]) * wg[4], bfs2f(t1[1]) * wg[5]); pk.w = cvt_pk_bf16(bfs2f(t1[2]) * wg[6], bfs2f(t1[3]) * wg[7]);
            B[nt] = __builtin_bit_cast(bf16x8, pk); }
#pragma unroll
        for (int pt = 0; pt < 2; ++pt)
#pragma unroll
            for (int nt = 0; nt < 2; ++nt) acc[pt][nt] = MFMA32(A[pt], B[nt], acc[pt][nt]);
    }
    unsigned* So = (unsigned*)STATES + ((size_t)(c * 32 + hd) * 64) * 64;
    const bool odd = lane & 1;
#pragma unroll
    for (int pt = 0; pt < 2; ++pt)
#pragma unroll
        for (int nt = 0; nt < 2; ++nt)
#pragma unroll
            for (int i = 0; i < 16; i += 2) { const int p0 = 32 * pt + (i & 3) + 8 * (i >> 2) + 4 * h, n = 64 * nh + 32 * nt + (lane & 31);
                const float mine0 = acc[pt][nt][i], mine1 = acc[pt][nt][i + 1];
                const float got = __int_as_float(__builtin_amdgcn_update_dpp(0, __float_as_int(odd ? mine0 : mine1), 0xB1, 0xf, 0xf, true));
                const unsigned w = odd ? cvt_pk_bf16(got, mine1) : cvt_pk_bf16(mine0, got);
                So[(p0 + (odd ? 1 : 0)) * 64 + (n >> 1)] = w; }
    if (nh == 0 && lane == 0) CDEC[c * 32 + hd] = __expf(alast);
}

__device__ __forceinline__ void ssd_scan(const float* __restrict__ STATES, const float* __restrict__ CDEC, bf16_t* __restrict__ PREV, size_t gt, size_t NGT) {
    typedef float f32x2 __attribute__((ext_vector_type(2)));
    for (size_t e = gt; e < (size_t)NSH * 64 * 128 / 2; e += NGT) {
        const int hd = (int)(e >> 12);
        f32x2 s = {0.f, 0.f};
        for (int cb = 0; cb < 128; cb += 16) {
            f32x2 v[16]; float d[16];
#pragma unroll
            for (int k = 0; k < 16; ++k) { const unsigned w = ((const unsigned*)STATES + (size_t)(cb + k) * NSH * 64 * 64)[e]; v[k][0] = __uint_as_float(w << 16); v[k][1] = __uint_as_float(w & 0xffff0000u); d[k] = CDEC[(cb + k) * 32 + hd]; }
#pragma unroll
            for (int k = 0; k < 16; ++k) { ((unsigned*)(PREV + (size_t)(cb + k) * NSH * 64 * 128))[e] = cvt_pk_bf16(s[0], s[1]); s = s * d[k] + v[k]; }
        }
    }
}

__device__ __forceinline__ void ssd_pass3_unit(LAS unsigned char* lds, const bf16_t* PREV, const float* dskip, const bf16_t* Z, bf16_t* MIX, float* rss, int c, int g, int tid, int lane, int wave) {
    const int r = wave >> 1, lh = wave & 1, h = lane >> 5, l31 = lane & 31, hd = 4 * g + r;
    LAS const unsigned char* xt = lds + SSD_XT + (r >> 1) * 32768; const unsigned xc = 2 * (r & 1);
    LAS const unsigned char* bt = lds + SSD_BT; LAS const unsigned char* ct = lds + SSD_CT;
    LAS const float* dtl = (LAS const float*)(lds + SSD_DT) + r * 128; LAS const float* acs = (LAS const float*)(lds + SSD_ACS) + r * 128;
    const float Dh = dskip[hd];
    f32x16 acc[2][2];
#pragma unroll
    for (int i = 0; i < 2; ++i)
#pragma unroll
        for (int j = 0; j < 2; ++j)
#pragma unroll
            for (int e = 0; e < 16; ++e) acc[i][j][e] = 0.f;
    {
        bf16x8 P[2][8]; const bf16_t* pv = PREV + ((size_t)(c * 32 + hd) * 64) * 128;
#pragma unroll
        for (int pt = 0; pt < 2; ++pt)
#pragma unroll
            for (int ks = 0; ks < 8; ++ks) P[pt][ks] = *(const bf16x8*)(pv + (32 * pt + l31) * 128 + 16 * ks + 8 * h);
#pragma unroll
        for (int lt = 0; lt < 2; ++lt) { const int l0 = 32 * (lt ? 3 - lh : lh);
#pragma unroll
            for (int ks = 0; ks < 8; ++ks) { const bf16x8 Cf = lds_row8(ct, l0 + l31, 2 * ks + h);
#pragma unroll
                for (int pt = 0; pt < 2; ++pt) acc[lt][pt] = MFMA32(Cf, P[pt][ks], acc[lt][pt]); }
#pragma unroll
            for (int q4 = 0; q4 < 4; ++q4) { const f32x4 a = *(LAS const f32x4*)(acs + l0 + 8 * q4 + 4 * h);
#pragma unroll
                for (int e = 0; e < 4; ++e) { const float f = __expf(a[e]); acc[lt][0][4 * q4 + e] *= f; acc[lt][1][4 * q4 + e] *= f; } } }
    }
#pragma unroll
    for (int lt = 0; lt < 2; ++lt) {
        const int gl = lt ? 3 - lh : lh, l0 = 32 * gl, lrow = l0 + l31; const float acs_l = acs[lrow];
        for (int st = 0; st <= gl; ++st) { const int s0 = 32 * st;
            f32x16 X;
#pragma unroll
            for (int e = 0; e < 16; ++e) X[e] = 0.f;
#pragma unroll
            for (int ks = 0; ks < 8; ++ks) { const bf16x8 Bf = lds_row8(bt, s0 + l31, 2 * ks + h), Cf = lds_row8(ct, l0 + l31, 2 * ks + h); X = MFMA32(Bf, Cf, X); }
            float w[16];
#pragma unroll
            for (int q4 = 0; q4 < 4; ++q4) { const int sb = s0 + 8 * q4 + 4 * h; const f32x4 as = *(LAS const f32x4*)(acs + sb), ds = *(LAS const f32x4*)(dtl + sb);
#pragma unroll
                for (int e = 0; e < 4; ++e) { const int s = sb + e; float v = X[4 * q4 + e] * __expf(fminf(acs_l - as[e], 0.f)) * ds[e]; v = (s <= lrow) ? v : 0.f; v = (s == lrow) ? v + Dh : v; w[4 * q4 + e] = v; } }
#pragma unroll
            for (int kp = 0; kp < 2; ++kp) { u32x4 pk; pk.x = cvt_pk_bf16(w[8 * kp + 0], w[8 * kp + 1]); pk.y = cvt_pk_bf16(w[8 * kp + 2], w[8 * kp + 3]); pk.z = cvt_pk_bf16(w[8 * kp + 4], w[8 * kp + 5]); pk.w = cvt_pk_bf16(w[8 * kp + 6], w[8 * kp + 7]);
                const bf16x8 Wf = __builtin_bit_cast(bf16x8, pk); const int rowb = s0 + 16 * kp + 4 * h;
#pragma unroll
                for (int pt = 0; pt < 2; ++pt) { const bf16x8 Xf = cat4(lds_tr4(xt, rowb, xc + pt, lane), lds_tr4(xt, rowb + 8, xc + pt, lane)); acc[lt][pt] = MFMA32(Wf, Xf, acc[lt][pt]); } }
        }
    }
    __syncthreads();
    const int row = tid >> 2, qd = tid & 3; const size_t trow = (size_t)(c * 128 + row);
    {
        const bf16_t* zp = Z + trow * DSSM + g * 256 + qd * 64;
#pragma unroll
        for (int j = 0; j < 8; ++j) *(LAS u32x4*)(lds + row * 512 + qd * 128 + j * 16) = *(const u32x4*)(zp + j * 8);
    }
    __syncthreads();
#pragma unroll
    for (int lt = 0; lt < 2; ++lt)
#pragma unroll
        for (int pt = 0; pt < 2; ++pt)
#pragma unroll
            for (int i = 0; i < 16; ++i) { const int l = 32 * (lt ? 3 - lh : lh) + (i & 3) + 8 * (i >> 2) + 4 * h, col = 64 * r + 32 * pt + l31;
                LAS unsigned short* zp = (LAS unsigned short*)(lds + l * 512 + col * 2); const float zv = bf2f(*zp);
                *zp = (unsigned short)(cvt_pk_bf16(acc[lt][pt][i] * silu_f(zv), 0.f) & 0xffffu); }
    __syncthreads();
    {
        bf16_t* op = MIX + trow * DM + g * 256 + qd * 64; float ss = 0.f;
#pragma unroll
        for (int j = 0; j < 8; ++j) { const u32x4 v = *(LAS const u32x4*)(lds + row * 512 + qd * 128 + j * 16); float f[8]; unpack8(v, f);
#pragma unroll
            for (int e = 0; e < 8; ++e) ss += f[e] * f[e];
            *(u32x4*)(op + j * 8) = v; }
        ss += __shfl_xor(ss, 1); ss += __shfl_xor(ss, 2);
        if (qd == 0) unsafeAtomicAdd(rss + trow, ss);
    }
    __syncthreads();
}
constexpr int ATT_K = 0, ATT_V = 32768;
__device__ __forceinline__ unsigned off64(unsigned row, unsigned ch) { return 128u * row + 16u * (ch ^ (row & 7)); }
__device__ __forceinline__ s16x4 lds_tr4_64(LAS const unsigned char* tile, unsigned rowbase, unsigned c32, unsigned lane) {
    const unsigned blk = (lane >> 4) & 1, q = (lane & 15) >> 2, p = lane & 3;
    LAS const unsigned char* a = tile + off64(rowbase + q, 4 * c32 + 2 * blk + (p >> 1)) + 8 * (p & 1);
    return __builtin_bit_cast(s16x4, __builtin_amdgcn_ds_read_tr16_b64_v4i16((LAS s16x4*)a));
}
__device__ __forceinline__ void attn_unit(LAS unsigned char* lds, const bf16_t* Q, const bf16_t* Kb, const bf16_t* V, const float* sinks, bf16_t* MIX, int nb, int kv, int tid, int lane, int wave) {
    const int hq = kv * 8 + wave, h = lane >> 5, l31 = lane & 31;
    bf16x8 Qf[4];
#pragma unroll
    for (int ks = 0; ks < 4; ++ks) Qf[ks] = *(const bf16x8*)(Q + (size_t)(128 * nb + l31) * 2048 + hq * 64 + 16 * ks + 8 * h);
#pragma unroll
    for (int j = 0; j < 4; ++j) { const int idx = tid + 512 * j, row = idx >> 3, ch = idx & 7; int tok = 128 * (nb - 1) + row; tok = tok < 0 ? 0 : tok;
        const size_t go = (size_t)tok * 256 + kv * 64 + ch * 8;
        *(LAS u32x4*)(lds + ATT_K + off64(row, ch)) = *(const u32x4*)(Kb + go);
        *(LAS u32x4*)(lds + ATT_V + off64(row, ch)) = *(const u32x4*)(V + go); }
    __syncthreads();
    const float sink = sinks[hq];
    LAS const unsigned char* kt_ = lds + ATT_K; LAS const unsigned char* vt_ = lds + ATT_V;
    for (int sb = 0; sb < 4; ++sb) {
        const size_t qrow = (size_t)(128 * nb + 32 * sb + l31);
        f32x16 S[5];
#pragma unroll
        for (int rel = 0; rel < 5; ++rel) {
#pragma unroll
            for (int e = 0; e < 16; ++e) S[rel][e] = 0.f;
#pragma unroll
            for (int ks = 0; ks < 4; ++ks) { const bf16x8 Kf = *(LAS const bf16x8*)(kt_ + off64(32 * (sb + rel) + l31, 2 * ks + h)); S[rel] = MFMA32(Kf, Qf[ks], S[rel]); }
        }
        if (sb < 3) {
#pragma unroll
            for (int ks = 0; ks < 4; ++ks) Qf[ks] = *(const bf16x8*)(Q + (qrow + 32) * 2048 + hq * 64 + 16 * ks + 8 * h); }
        float m = -1e30f;
#pragma unroll
        for (int rel = 0; rel < 5; ++rel) { const bool tile_ok = (nb > 0) || (sb + rel >= 4);
#pragma unroll
            for (int i = 0; i < 16; ++i) { const int kr = (i & 3) + 8 * (i >> 2) + 4 * h; bool ok = tile_ok;
                if (rel == 0) ok = ok && (kr > l31);
                if (rel == 4) ok = ok && (kr <= l31);
                const float s = ok ? S[rel][i] * 0.125f : -1e30f; S[rel][i] = s; m = fmaxf(m, s); } }
        m = fmaxf(m, __shfl_xor(m, 32)); m = fmaxf(m, sink);
        float lsum = 0.f;
#pragma unroll
        for (int rel = 0; rel < 5; ++rel)
#pragma unroll
            for (int i = 0; i < 16; ++i) { const float p = __expf(S[rel][i] - m); S[rel][i] = p; lsum += p; }
        lsum += __shfl_xor(lsum, 32); lsum += __expf(sink - m);
        f32x16 O[2];
#pragma unroll
        for (int dt = 0; dt < 2; ++dt)
#pragma unroll
            for (int e = 0; e < 16; ++e) O[dt][e] = 0.f;
#pragma unroll
        for (int rel = 0; rel < 5; ++rel)
#pragma unroll
            for (int kp = 0; kp < 2; ++kp) { u32x4 pk; pk.x = cvt_pk_bf16(S[rel][8 * kp + 0], S[rel][8 * kp + 1]); pk.y = cvt_pk_bf16(S[rel][8 * kp + 2], S[rel][8 * kp + 3]);
                pk.z = cvt_pk_bf16(S[rel][8 * kp + 4], S[rel][8 * kp + 5]); pk.w = cvt_pk_bf16(S[rel][8 * kp + 6], S[rel][8 * kp + 7]);
                const bf16x8 Pf = __builtin_bit_cast(bf16x8, pk); const int rowb = 32 * (sb + rel) + 16 * kp + 4 * h;
#pragma unroll
                for (int dt = 0; dt < 2; ++dt) { const bf16x8 Vf = cat4(lds_tr4_64(vt_, rowb, dt, lane), lds_tr4_64(vt_, rowb + 8, dt, lane)); O[dt] = MFMA32(Vf, Pf, O[dt]); } }
        const float inv = 1.f / lsum;
        bf16_t* op = MIX + qrow * DM + 2048 + hq * 64;
#pragma unroll
        for (int dt = 0; dt < 2; ++dt)
#pragma unroll
            for (int i4 = 0; i4 < 4; ++i4) { f32x4 v; v[0] = O[dt][4 * i4] * inv; v[1] = O[dt][4 * i4 + 1] * inv; v[2] = O[dt][4 * i4 + 2] * inv; v[3] = O[dt][4 * i4 + 3] * inv;
                *(u32x2*)(op + 32 * dt + 8 * i4 + 4 * h) = pack4(v); }
    }
    __syncthreads();
}
typedef int i32x4 __attribute__((ext_vector_type(4)));
__device__ __forceinline__ f32x4 acc_i2f(const f32x4 a) { return __builtin_convertvector(__builtin_bit_cast(i32x4, a), f32x4); }
__device__ __forceinline__ u32x2 pack8_i8(const f32x4 a, const f32x4 b) {
    u32x2 w; w.x = (unsigned)((int)a[0] & 255) | ((unsigned)((int)a[1] & 255) << 8) | ((unsigned)((int)a[2] & 255) << 16) | ((unsigned)(int)a[3] << 24);
    w.y = (unsigned)((int)b[0] & 255) | ((unsigned)((int)b[1] & 255) << 8) | ((unsigned)((int)b[2] & 255) << 16) | ((unsigned)(int)b[3] << 24); return w; }
struct EpiInProj {
    static constexpr bool I8 = false, APERM = false, PERM = false, AFTER_DRAIN = false, HAS_MID = false; int tmid;
    bf16_t *Q, *Kb, *V, *Z, *XBC; float* DT; const float *rs0, *cosT, *sinT, *dt_bias;
    __device__ __forceinline__ void mid(f32x4 (&)[2][2][4][2], const pg8::Unit&, int, int) const {}
    __device__ __forceinline__ void operator()(const f32x4 (&acc)[2][2][4][2], const pg8::Unit& u, int wr, int wc, int fr, int fq) const {
        const int row0 = u.pm * 256 + wr * 64 + fr, pn = u.pn;
        if (pn < 9) {
            bf16_t* base = pn < 8 ? Q : Kb; const int ld = pn < 8 ? 2048 : 256, hb = pn < 8 ? pn * 4 : 0, dlo = 16 * (wc & 1) + 4 * fq;
#pragma unroll
            for (int ai = 0; ai < 2; ++ai) {
                float sv[4]; f32x4 cv[4], sn[4];
#pragma unroll
                for (int m = 0; m < 4; ++m) { const int row = row0 + ai * 128 + m * 16; sv[m] = rs0[row];
                    cv[m] = *(const f32x4*)(cosT + (size_t)row * 32 + dlo); sn[m] = *(const f32x4*)(sinT + (size_t)row * 32 + dlo); }
                asm volatile("" ::: "memory");
#pragma unroll
                for (int m = 0; m < 4; ++m) { const int row = row0 + ai * 128 + m * 16; const float s = sv[m]; const f32x4 c4 = cv[m], s4 = sn[m];
#pragma unroll
                    for (int bj = 0; bj < 2; ++bj) { const int hh = hb + 2 * bj + (wc >> 1); const f32x4 x1 = acc[ai][bj][m][0], x2 = acc[ai][bj][m][1];
                        const f32x4 o1 = (x1 * c4 - x2 * s4) * s, o2 = (x2 * c4 + x1 * s4) * s;
                        bf16_t* dst = base + (size_t)row * ld + hh * 64 + dlo;
                        *(u32x2*)dst = pack4(o1); *(u32x2*)(dst + 32) = pack4(o2); } }
                asm volatile("" ::: "memory"); }
        } else if (pn < 34) {
            bf16_t* base; int ld, col0;
            if (pn == 9) { base = V; ld = 256; col0 = 0; } else if (pn < 18) { base = Z; ld = 2048; col0 = (pn - 10) * 256; } else { base = XBC; ld = 4096; col0 = (pn - 18) * 256; }
            col0 += wc * 32 + 8 * fq;
            float sv[2][4];
#pragma unroll
            for (int ai = 0; ai < 2; ++ai)
#pragma unroll
                for (int m = 0; m < 4; ++m) sv[ai][m] = rs0[row0 + ai * 128 + m * 16];
            asm volatile("" ::: "memory");
#pragma unroll
            for (int ai = 0; ai < 2; ++ai)
#pragma unroll
                for (int m = 0; m < 4; ++m) { const int row = row0 + ai * 128 + m * 16; const float s = sv[ai][m];
#pragma unroll
                    for (int bj = 0; bj < 2; ++bj) *(u32x4*)(base + (size_t)row * ld + col0 + bj * 128) = pack8(acc[ai][bj][m][0] * s, acc[ai][bj][m][1] * s); }
        } else if (wc == 0) {
            const f32x4 b0 = *(const f32x4*)(dt_bias + 8 * fq), b1 = *(const f32x4*)(dt_bias + 8 * fq + 4);
            float sv[2][4];
#pragma unroll
            for (int ai = 0; ai < 2; ++ai)
#pragma unroll
                for (int m = 0; m < 4; ++m) sv[ai][m] = rs0[row0 + ai * 128 + m * 16];
            asm volatile("" ::: "memory");
#pragma unroll
            for (int ai = 0; ai < 2; ++ai)
#pragma unroll
                for (int m = 0; m < 4; ++m) { const int row = row0 + ai * 128 + m * 16; const float s = sv[ai][m];
                    f32x4 v0 = acc[ai][0][m][0] * s + b0, v1 = acc[ai][0][m][1] * s + b1;
#pragma unroll
                    for (int e = 0; e < 4; ++e) { v0[e] = softplus_f(v0[e]); v1[e] = softplus_f(v1[e]); }
                    *(f32x4*)(DT + (size_t)row * 32 + 8 * fq) = v0; *(f32x4*)(DT + (size_t)row * 32 + 8 * fq + 4) = v1; }
        }
    }
};
struct EpiWo {
    static constexpr bool I8 = false, APERM = false, PERM = false, AFTER_DRAIN = false, HAS_MID = true; int tmid;
    const float* x; bf16_t* HB; const float* rss_ssm; float* rss1; signed char* HQ; const float* rs0;
    __device__ __forceinline__ void mid(f32x4 (&acc)[2][2][4][2], const pg8::Unit& u, int wr, int fr) const {
#pragma unroll
        for (int ai = 0; ai < 2; ++ai)
#pragma unroll
            for (int m = 0; m < 4; ++m) { const int row = u.pm * 256 + wr * 64 + fr + ai * 128 + m * 16; const float sc = rsqrtf(rss_ssm[row] * (1.f / DSSM) + EPS);
#pragma unroll
                for (int bj = 0; bj < 2; ++bj)
#pragma unroll
                    for (int n = 0; n < 2; ++n) acc[ai][bj][m][n] *= sc; }
    }
    __device__ __forceinline__ void operator()(const f32x4 (&acc)[2][2][4][2], const pg8::Unit& u, int wr, int wc, int fr, int fq) const {
        const int row0 = u.pm * 256 + wr * 64 + fr, col0 = u.pn * 256 + wc * 32 + 8 * fq;
        f32x4 xr[2][2][2][2]; float iqv[2][2];
#define WO_LOAD(b) do { _Pragma("unroll") for (int mm = 0; mm < 2; ++mm) { const int row = row0 + ((b) >> 1) * 128 + (2 * ((b) & 1) + mm) * 16; iqv[(b) & 1][mm] = rs0[row]; \
            _Pragma("unroll") for (int bj = 0; bj < 2; ++bj) { const size_t off = (size_t)row * DM + col0 + bj * 128; xr[(b) & 1][mm][bj][0] = *(const f32x4*)(x + off); xr[(b) & 1][mm][bj][1] = *(const f32x4*)(x + off + 4); } } } while (0)
        WO_LOAD(0);
#pragma unroll
        for (int b = 0; b < 4; ++b) { const int ai = b >> 1, mp = b & 1;
            if (b < 3) WO_LOAD(b + 1);
            asm volatile("" ::: "memory");
#pragma unroll
            for (int mm = 0; mm < 2; ++mm) { const int m = 2 * mp + mm, row = row0 + ai * 128 + m * 16; float ss = 0.f; const float iq = (127.f / QCLIP) * iqv[b & 1][mm];
#pragma unroll
                for (int bj = 0; bj < 2; ++bj) { const size_t off = (size_t)row * DM + col0 + bj * 128;
                    const f32x4 h0 = xr[b & 1][mm][bj][0] + acc[ai][bj][m][0], h1 = xr[b & 1][mm][bj][1] + acc[ai][bj][m][1];
                    *(u32x4*)(HB + off) = pack8(h0, h1);
                    { f32x4 q0, q1;
#pragma unroll
                      for (int ee = 0; ee < 4; ++ee) { q0[ee] = fminf(fmaxf(rintf(h0[ee] * iq), -127.f), 127.f); q1[ee] = fminf(fmaxf(rintf(h1[ee] * iq), -127.f), 127.f); }
                      *(u32x2*)(HQ + off) = pack8_i8(q0, q1); }
                    ss += (h0[0] * h0[0] + h0[1] * h0[1]) + (h0[2] * h0[2] + h0[3] * h0[3]) + (h1[0] * h1[0] + h1[1] * h1[1]) + (h1[2] * h1[2] + h1[3] * h1[3]); }
                ss += __shfl_xor(ss, 16); ss += __shfl_xor(ss, 32);
                if (fq == 0) unsafeAtomicAdd(rss1 + row, ss); }
                asm volatile("" ::: "memory"); }
    }
};
#undef WO_LOAD
struct EpiUpPlain {
    static constexpr bool I8 = false, APERM = false, PERM = false, AFTER_DRAIN = false, HAS_MID = false; int tmid;
    bf16_t* U; const float* rss1;
    __device__ __forceinline__ void mid(f32x4 (&)[2][2][4][2], const pg8::Unit&, int, int) const {}
    __device__ __forceinline__ void operator()(const f32x4 (&acc)[2][2][4][2], const pg8::Unit& u, int wr, int wc, int fr, int fq) const {
        const int row0 = u.pm * 256 + wr * 64 + fr, col0 = u.pn * 256 + wc * 32 + 8 * fq;
#pragma unroll
        for (int ai = 0; ai < 2; ++ai)
#pragma unroll
            for (int m = 0; m < 4; ++m) { const int row = row0 + ai * 128 + m * 16; const float s = rsqrtf(rss1[row] * (1.f / DM) + EPS);
#pragma unroll
                for (int bj = 0; bj < 2; ++bj) *(u32x4*)(U + (size_t)row * DFF + col0 + bj * 128) = pack8(acc[ai][bj][m][0] * s, acc[ai][bj][m][1] * s); }
    }
};
struct EpiDown {
    static constexpr bool I8 = false, APERM = false, PERM = false, AFTER_DRAIN = false, HAS_MID = false; int tmid;
    bf16_t* HB; signed char* HQ; const float* rss1;
    __device__ __forceinline__ void mid(f32x4 (&)[2][2][4][2], const pg8::Unit&, int, int) const {}
    __device__ __forceinline__ void operator()(const f32x4 (&acc)[2][2][4][2], const pg8::Unit& u, int wr, int wc, int fr, int fq) const {
        const int row0 = u.pm * 256 + wr * 64 + fr, col0 = u.pn * 256 + wc * 32 + 8 * fq;
#pragma unroll
        for (int ai = 0; ai < 2; ++ai) {
            u32x4 hr[4][2]; float q1v[4];
#pragma unroll
            for (int m = 0; m < 4; ++m) { q1v[m] = rss1[row0 + ai * 128 + m * 16];
#pragma unroll
                for (int bj = 0; bj < 2; ++bj) hr[m][bj] = *(const u32x4*)(HB + (size_t)(row0 + ai * 128 + m * 16) * DM + col0 + bj * 128); }
#pragma unroll
            for (int m = 0; m < 4; ++m) { const float iq = (127.f / QCLIP) * rsqrtf(q1v[m] * (1.f / DM) + EPS);
#pragma unroll
                for (int bj = 0; bj < 2; ++bj) { float hv[8]; unpack8(hr[m][bj], hv); const size_t off = (size_t)(row0 + ai * 128 + m * 16) * DM + col0 + bj * 128;
                    f32x4 h0 = acc[ai][bj][m][0], h1 = acc[ai][bj][m][1];
#pragma unroll
                    for (int e = 0; e < 4; ++e) { h0[e] += hv[e]; h1[e] += hv[4 + e]; }
                    *(u32x4*)(HB + off) = pack8(h0, h1);
                    f32x4 q0, q1;
#pragma unroll
                    for (int ee = 0; ee < 4; ++ee) { q0[ee] = fminf(fmaxf(rintf(h0[ee] * iq), -127.f), 127.f); q1[ee] = fminf(fmaxf(rintf(h1[ee] * iq), -127.f), 127.f); }
                    *(u32x2*)(HQ + off) = pack8_i8(q0, q1); } }
            asm volatile("" ::: "memory"); }
    }
};
struct EpiBf {
    static constexpr bool I8 = false, APERM = false, PERM = false, AFTER_DRAIN = false, HAS_MID = false; int tmid;
    bf16_t* O; int ldo;
    __device__ __forceinline__ void mid(f32x4 (&)[2][2][4][2], const pg8::Unit&, int, int) const {}
    __device__ __forceinline__ void operator()(const f32x4 (&acc)[2][2][4][2], const pg8::Unit& u, int wr, int wc, int fr, int fq) const {
        const int row0 = u.pm * 256 + wr * 64 + fr, col0 = u.pn * 256 + wc * 32 + 8 * fq;
#pragma unroll
        for (int ai = 0; ai < 2; ++ai)
#pragma unroll
            for (int m = 0; m < 4; ++m) { const int row = row0 + ai * 128 + m * 16;
#pragma unroll
                for (int bj = 0; bj < 2; ++bj) *(u32x4*)(O + (size_t)row * ldo + col0 + bj * 128) = pack8(acc[ai][bj][m][0], acc[ai][bj][m][1]); }
    }
};
struct EpiGate {
    static constexpr bool I8 = true, APERM = false, PERM = false, AFTER_DRAIN = false, HAS_MID = false; int tmid;
    float* H; const bf16_t* HB; const bf16_t* PP; const float* bg; float* rss3; const float* rss1; const float* cmax;
    __device__ __forceinline__ void mid(f32x4 (&)[2][2][4][2], const pg8::Unit&, int, int) const {}
    __device__ __forceinline__ void operator()(const f32x4 (&acc)[2][2][4][2], const pg8::Unit& u, int wr, int wc, int fr, int fq) const {
        const int row0 = u.pm * 256 + wr * 64 + fr, col0 = u.pn * 256 + wc * 32 + 8 * fq;
        f32x4 bv[2][2], sb[2][2];
#pragma unroll
        for (int bj = 0; bj < 2; ++bj) { bv[bj][0] = *(const f32x4*)(bg + col0 + bj * 128); bv[bj][1] = *(const f32x4*)(bg + col0 + bj * 128 + 4);
            sb[bj][0] = *(const f32x4*)(cmax + col0 + bj * 128) * (1.f / 127.f); sb[bj][1] = *(const f32x4*)(cmax + col0 + bj * 128 + 4) * (1.f / 127.f); }
        u32x4 hr[2][2], pr[2][2]; float q1v[2];
#define GT_LOAD(b) do { const int row_ = row0 + ((b) >> 2) * 128 + ((b) & 3) * 16; q1v[(b) & 1] = rss1[row_]; \
            _Pragma("unroll") for (int bj = 0; bj < 2; ++bj) { const size_t off = (size_t)row_ * DM + col0 + bj * 128; hr[(b) & 1][bj] = *(const u32x4*)(HB + off); pr[(b) & 1][bj] = *(const u32x4*)(PP + off); } } while (0)
        GT_LOAD(0);
#pragma unroll
        for (int b = 0; b < 8; ++b) { const int ai = b >> 2, m = b & 3, row = row0 + ai * 128 + m * 16;
            if (b < 7) GT_LOAD(b + 1);
            asm volatile("" ::: "memory");
            float ss = 0.f; const float sa = (QCLIP / 127.f) * sqrtf(q1v[b & 1] * (1.f / DM) + EPS);
#pragma unroll
            for (int bj = 0; bj < 2; ++bj) { const size_t off = (size_t)row * DM + col0 + bj * 128;
                float pv[8], hv[8]; unpack8(pr[b & 1][bj], pv); unpack8(hr[b & 1][bj], hv);
                const f32x4 g0 = acc_i2f(acc[ai][bj][m][0]) * (sb[bj][0] * sa) + bv[bj][0], g1 = acc_i2f(acc[ai][bj][m][1]) * (sb[bj][1] * sa) + bv[bj][1]; f32x4 h0, h1;
#pragma unroll
                for (int e = 0; e < 4; ++e) { h0[e] = hv[e] + pv[e] * sigm_f(g0[e]); h1[e] = hv[4 + e] + pv[4 + e] * sigm_f(g1[e]); }
                *(f32x4*)(H + off) = h0; *(f32x4*)(H + off + 4) = h1;
                ss += (h0[0] * h0[0] + h0[1] * h0[1]) + (h0[2] * h0[2] + h0[3] * h0[3]) + (h1[0] * h1[0] + h1[1] * h1[1]) + (h1[2] * h1[2] + h1[3] * h1[3]); }
            ss += __shfl_xor(ss, 16); ss += __shfl_xor(ss, 32);
            if (fq == 0) unsafeAtomicAdd(rss3 + row, ss);
                asm volatile("" ::: "memory"); }
    }
};


__device__ __forceinline__ float dpp_shr1z(float src) { return __int_as_float(__builtin_amdgcn_update_dpp(0, __float_as_int(src), 0x111, 0xf, 0xf, true)); }
__device__ __forceinline__ f32x4 shr1z4(const f32x4 a) { f32x4 r; r[0] = dpp_shr1z(a[0]); r[1] = dpp_shr1z(a[1]); r[2] = dpp_shr1z(a[2]); r[3] = dpp_shr1z(a[3]); return r; }
struct EpiUpConv {
    static constexpr bool I8 = true, APERM = true, PERM = false, AFTER_DRAIN = false, HAS_MID = false; int tmid;
    bf16_t* ACT; const float* rss1; const float* cw; const float* cb; LAS float* X; const float* rs0; const float* cmax;
    __device__ __forceinline__ void mid(f32x4 (&)[2][2][4][2], const pg8::Unit&, int, int) const {}
    __device__ __forceinline__ void conv4(f32x4 (&y)[4], const f32x4 (&x)[4], LAS const float* wl) const {
        const f32x4 w0 = *(LAS const f32x4*)wl, w1 = *(LAS const f32x4*)(wl + 128), w2 = *(LAS const f32x4*)(wl + 256), b = *(LAS const f32x4*)(wl + 384);
        const f32x4 x1 = shr1z4(x[3]), x2 = shr1z4(x[2]);
        y[0] = b + w2 * x[0] + w1 * x1 + w0 * x2;
        y[1] = b + w2 * x[1] + w1 * x[0] + w0 * x1;
        y[2] = b + w2 * x[2] + w1 * x[1] + w0 * x[0];
        y[3] = b + w2 * x[3] + w1 * x[2] + w0 * x[1];
    }
    __device__ __forceinline__ void operator()(const f32x4 (&acc)[2][2][4][2], const pg8::Unit& u, int wr, int wc, int fr, int fq) const {
        const int T0 = 254 * u.pm - 2, colp = wc * 32 + 8 * fq, cbase = u.pn * 128 + colp;
        LAS float* WL = X + 2048;
        typedef float f32x2 __attribute__((ext_vector_type(2)));
        const int tid = (wr * 4 + wc) * 64 + fq * 16 + fr, q = tid >> 6, c2 = (tid & 63) * 2, gu = q >> 2, k = q & 3;
        const float* src = (k < 3 ? cw + (size_t)k * 2 * DFF : cb) + gu * DFF + u.pn * 128 + c2;
        f32x2 wv = *(const f32x2*)src;
        const f32x2 cm = *(const f32x2*)(cmax + gu * DFF + u.pn * 128 + c2);
        float qv[2][4], r0v[2][4];
#pragma unroll
        for (int ai = 0; ai < 2; ++ai)
#pragma unroll
            for (int m = 0; m < 4; ++m) { const int t = T0 + ai * 128 + wr * 64 + 4 * fr + m; const int tc = ((t >= 0) && (t < SEQ)) ? t : 0; qv[ai][m] = rss1[tc]; r0v[ai][m] = rs0[tc]; }
        asm volatile("" ::: "memory");
        if (k < 3) wv = wv * cm * (1.f / 127.f);
        *(LAS f32x2*)(WL + q * 128 + c2) = wv;
        float rs[2][4];
#pragma unroll
        for (int ai = 0; ai < 2; ++ai)
#pragma unroll
            for (int m = 0; m < 4; ++m) { const int t = T0 + ai * 128 + wr * 64 + 4 * fr + m; const bool ok = (t >= 0) && (t < SEQ);
                rs[ai][m] = ok ? rsqrtf(qv[ai][m] * (1.f / DM) + EPS) * (QCLIP / 127.f) * __builtin_amdgcn_rcpf(r0v[ai][m]) : 0.f; }
        if (fr == 15) {
#pragma unroll
            for (int ai = 0; ai < 2; ++ai)
#pragma unroll
                for (int bj = 0; bj < 2; ++bj)
#pragma unroll
                    for (int n = 0; n < 2; ++n) { *(LAS f32x4*)(X + ((2 * ai + wr) * 2 + 0) * 256 + bj * 128 + colp + 4 * n) = acc_i2f(acc[ai][bj][2][n]) * rs[ai][2];
                                                  *(LAS f32x4*)(X + ((2 * ai + wr) * 2 + 1) * 256 + bj * 128 + colp + 4 * n) = acc_i2f(acc[ai][bj][3][n]) * rs[ai][3]; }
        }
        asm volatile("s_waitcnt lgkmcnt(0)" ::: "memory"); __builtin_amdgcn_s_barrier(); asm volatile("" ::: "memory");
#pragma unroll
        for (int ai = 0; ai < 2; ++ai) {
            const int pb = 2 * ai + wr - 1;
#pragma unroll
            for (int n = 0; n < 2; ++n) {
                const int cl = colp + 4 * n, cch = cbase + 4 * n;
                asm volatile("" ::: "memory");
                f32x4 yg[4], yu[4];
                { f32x4 x[4];
#pragma unroll
                  for (int m = 0; m < 4; ++m) x[m] = acc_i2f(acc[ai][0][m][n]) * rs[ai][m];
                  conv4(yg, x, WL + cl); }
                asm volatile("" : "+v"(yg[0]), "+v"(yg[1]), "+v"(yg[2]), "+v"(yg[3]) :: "memory");
                { f32x4 x[4];
#pragma unroll
                  for (int m = 0; m < 4; ++m) x[m] = acc_i2f(acc[ai][1][m][n]) * rs[ai][m];
                  conv4(yu, x, WL + 512 + cl); }
                if (fr == 0 && pb >= 0) {
                    const f32x4 h1g = *(LAS const f32x4*)(X + (pb * 2 + 1) * 256 + cl), h2g = *(LAS const f32x4*)(X + (pb * 2) * 256 + cl);
                    const f32x4 h1u = *(LAS const f32x4*)(X + (pb * 2 + 1) * 256 + 128 + cl), h2u = *(LAS const f32x4*)(X + (pb * 2) * 256 + 128 + cl);
                    const f32x4 g0 = *(LAS const f32x4*)(WL + cl), g1 = *(LAS const f32x4*)(WL + 128 + cl), u0 = *(LAS const f32x4*)(WL + 512 + cl), u1 = *(LAS const f32x4*)(WL + 640 + cl);
                    yg[0] += g1 * h1g + g0 * h2g; yg[1] += g0 * h1g; yu[0] += u1 * h1u + u0 * h2u; yu[1] += u0 * h1u;
                }
#pragma unroll
                for (int m = 0; m < 4; ++m) { const int R = ai * 128 + wr * 64 + 4 * fr + m, t = T0 + R; f32x4 o;
#pragma unroll
                    for (int e = 0; e < 4; ++e) o[e] = silu_f(yg[m][e]) * yu[m][e];
                    if (R >= 2 && t < SEQ) *(u32x2*)(ACT + (size_t)t * DFF + cch) = pack4(o); }
            }
        }
    }
};
constexpr int LDS_BYTES = 147456;
constexpr int RING_BYTES = 131072, MISC_OFF = RING_BYTES + 320;
constexpr int N_PHASES = 10;
struct Args { const float* in[22]; float* out; unsigned char* ws; int ph_lo, ph_hi, li, pad; };
struct PpOrder {
    int c, G;
    __device__ __forceinline__ bool next(int i, pg8::Unit& u) const {
        int L;
        if (G == 256) { if (c < 192) { if (i >= 2) return false; L = c * 2 + i; } else { if (i >= 10) return false; L = 384 + (c - 192) * 10 + i; } }
        else { L = i * G + c; if (L >= 1024) return false; }
        u.pm = L >> 4; u.pn = L & 15; return true;
    }
    __device__ __forceinline__ void a_ready(const pg8::Unit&) const {}
    __device__ __forceinline__ void done(const pg8::Unit&) const {}
};
typedef const __attribute__((address_space(4))) Args* ArgsP;
__device__ __forceinline__ ArgsP fresh_args() { ArgsP p = (ArgsP)__builtin_amdgcn_kernarg_segment_ptr(); asm volatile("" : "+s"(p)); return p; }
__device__ __forceinline__ int fresh_tid() { int t = threadIdx.x; asm volatile("" : "+v"(t)); return t; }
#define PH_IDS() ArgsP ap = fresh_args(); unsigned char* ws = ap->ws; float* ctl = (float*)(ws + WS_CTL); const int tid = fresh_tid(), lane = tid & 63, wave = __builtin_amdgcn_readfirstlane(tid >> 6); \
    const int G = gridDim.x, c = blockIdx.x, gw = c * 8 + wave, NGW = G * 8; const size_t gt = (size_t)c * 512 + tid, NGT = (size_t)G * 512; \
    (void)ctl; (void)lane; (void)gw; (void)NGW; (void)gt; (void)NGT; (void)ws
__global__ void __launch_bounds__(512, 2) k_fwd(Args a_unused) {
    extern __shared__ __attribute__((aligned(16))) unsigned char lds_raw[];
    LAS unsigned char* lds = (LAS unsigned char*)lds_raw;
    int lo, hi;
    XcdBarrier bar;
    {   PH_IDS();
        volatile LAS unsigned* MISC = (volatile LAS unsigned*)(lds + MISC_OFF);
        for (int u = tid; u < (LDS_BYTES - RING_BYTES) / 4; u += 512) ((LAS unsigned*)(lds + RING_BYTES))[u] = 0u;
        __syncthreads();
        bar = xcd_barrier_post((unsigned*)ctl + CW_BAR + ap->li * XCD_BAR_WORDS, MISC + 8);
        lo = ap->ph_lo; hi = ap->ph_hi; }
#define IN(k) (lo <= (k) && (k) < hi)
#define SEAM(k) do { if (IN(k) && IN((k) + 1)) xcd_barrier(bar); } while (0)

    if (IN(0)) { PH_IDS();
        LAS unsigned* scr = (LAS unsigned*)(lds + wave * 16384);
        TrJob j; j.pad = 0; j.qmax = nullptr;
        j.W = ap->in[4]; j.WT = (bf16_t*)(ws + WS_WIN); j.kscale = ap->in[3]; j.K = DM; j.N = NPROJ; j.nrows = NPROJ_PAD; j.kind = 1; j.kxor = 0; j.kscale_n = DM; ph_transpose(j, scr, gw, NGW, lane);
        j.kscale = nullptr; j.K = DM; j.N = DM; j.nrows = DM; j.kind = 0; j.kxor = 0; j.kscale_n = 0;
        j.W = ap->in[20]; j.WT = (bf16_t*)(ws + WS_WP); j.K = PLE; ph_transpose(j, scr, gw, NGW, lane);
        ph_xprep(ap->in[0], (bf16_t*)(ws + WS_XB), (float*)(ws + WS_RS0), gw, NGW, lane);
        ph_pprep(ap->in[1], (bf16_t*)(ws + WS_PB), gt, NGT);
        ph_trig((const int*)ap->in[2], (float*)(ws + WS_COS), (float*)(ws + WS_SIN), gt, NGT);
    }
    SEAM(0);
    if (IN(1)) { PH_IDS();
        { pg8::Gemm g{(const bf16_t*)(ws + WS_XB), (const bf16_t*)(ws + WS_WIN), SEQ, NPROJ_PAD, DM}; pg8::StaticOrder S; S.init(SEQ, NPROJ_PAD, G, c);
          EpiInProj E{0, (bf16_t*)(ws + WS_Q), (bf16_t*)(ws + WS_K), (bf16_t*)(ws + WS_V), (bf16_t*)(ws + WS_Z), (bf16_t*)(ws + WS_XBC), (float*)(ws + WS_DT),
                      (const float*)(ws + WS_RS0), (const float*)(ws + WS_COS), (const float*)(ws + WS_SIN), ap->in[8]};
          pg8::gemm_phase<EpiInProj, pg8::StaticOrder, true, true>(lds, g, S, E); }
        { pg8::Gemm g{(const bf16_t*)(ws + WS_PB), (const bf16_t*)(ws + WS_WP), SEQ, DM, PLE}; PpOrder S{c, G};
          EpiBf E{0, (bf16_t*)(ws + WS_PP), DM};
          pg8::gemm_phase<EpiBf, PpOrder, true, true>(lds, g, S, E); }
    }
    SEAM(1);
    if (IN(2)) { PH_IDS();
        for (int u = c; u < 512; u += G) attn_unit(lds, (const bf16_t*)(ws + WS_Q), (const bf16_t*)(ws + WS_K), (const bf16_t*)(ws + WS_V), ap->in[5], (bf16_t*)(ws + WS_MIX), u >> 2, u & 3, tid, lane, wave);
        for (int u = c; u < 1024; u += G) { const int ch = u >> 3, g = u & 7;
            ssd_stage<false>(lds, (const bf16_t*)(ws + WS_XBC), ap->in[6], ap->in[7], (const float*)(ws + WS_DT), ap->in[9], ch, g, tid, lane, wave);
            ssd_pass1_unit(lds, (float*)(ws + WS_STATES), (float*)(ws + WS_CDEC), ch, g, lane, wave);
            __syncthreads(); }
    }
    if (IN(2)) { PH_IDS();
        ph_colmax(ap->in[14], ap->in[13], DM, 2 * DFF, (unsigned*)ctl + CW_CMAX_UP, gw, NGW, lane);
        ph_colmax(ap->in[18], nullptr, DM, DM, (unsigned*)ctl + CW_CMAX_G, gw, NGW, lane);
    }
    SEAM(2);
    if (IN(3)) { PH_IDS(); ssd_scan((const float*)(ws + WS_STATES), (const float*)(ws + WS_CDEC), (bf16_t*)(ws + WS_PREV), gt, NGT);
        LAS unsigned* scr = (LAS unsigned*)(lds + wave * 16384);
        TrJob j; j.pad = 0; j.qmax = nullptr;
        j.W = ap->in[12]; j.WT = (bf16_t*)(ws + WS_WO); j.kscale = ap->in[11]; j.K = DM; j.N = DM; j.nrows = DM; j.kind = 0; j.kxor = 2048; j.kscale_n = 2048; ph_transpose(j, scr, gw, NGW, lane);
        j.qmax = ctl + CW_CMAX_UP; j.W = ap->in[14]; j.WT = (bf16_t*)(ws + WS_WUP); j.kscale = ap->in[13]; j.K = DM; j.N = 2 * DFF; j.nrows = 2 * DFF; j.kind = 2; j.kxor = 0; j.kscale_n = DM; ph_transpose_q8(j, scr, gw, NGW, lane); j.qmax = nullptr;
        j.W = ap->in[17]; j.WT = (bf16_t*)(ws + WS_WDN); j.kscale = nullptr; j.K = DFF; j.N = DM; j.nrows = DM; j.kind = 0; j.kxor = 0; j.kscale_n = 0; ph_transpose(j, scr, gw, NGW, lane);
        j.qmax = ctl + CW_CMAX_G; j.W = ap->in[18]; j.WT = (bf16_t*)(ws + WS_WG); j.K = DM; ph_transpose_q8(j, scr, gw, NGW, lane); j.qmax = nullptr;
    }
    SEAM(3);
    if (IN(4)) { PH_IDS();
        for (int u = c; u < 1024; u += G) { const int ch = u >> 3, g = u & 7;
            ssd_stage<true>(lds, (const bf16_t*)(ws + WS_XBC), ap->in[6], ap->in[7], (const float*)(ws + WS_DT), ap->in[9], ch, g, tid, lane, wave);
            ssd_pass3_unit(lds, (const bf16_t*)(ws + WS_PREV), ap->in[10], (const bf16_t*)(ws + WS_Z), (bf16_t*)(ws + WS_MIX), ctl + CW_RSS_SSM, ch, g, tid, lane, wave); }
    }
    SEAM(4);
    if (IN(5)) { PH_IDS();
        pg8::Gemm g{(const bf16_t*)(ws + WS_MIX), (const bf16_t*)(ws + WS_WO), SEQ, DM, DM}; pg8::StaticOrder S; S.init(SEQ, DM, G, c);
        EpiWo E{32, ap->in[0], (bf16_t*)(ws + WS_XB), ctl + CW_RSS_SSM, ctl + CW_RSS1, (signed char*)(ws + WS_H1Q), (const float*)(ws + WS_RS0)};
        pg8::gemm_phase<EpiWo, pg8::StaticOrder, true, true>(lds, g, S, E);
    }
    SEAM(5);
    if (IN(6)) { PH_IDS();
        pg8::Gemm g{(const bf16_t*)(ws + WS_H1Q - 2 * DM), (const bf16_t*)(ws + WS_WUP), 65 * 256, 2 * DFF, DM, (size_t)254 * DM};     pg8::StaticOrder S; S.init(65 * 256, 2 * DFF, G, c);
        EpiUpConv E{0, (bf16_t*)(ws + WS_ACT), ctl + CW_RSS1, ap->in[15], ap->in[16], (LAS float*)(lds + RING_BYTES + 1024), (const float*)(ws + WS_RS0), ctl + CW_CMAX_UP};
        pg8::gemm_phase<EpiUpConv, pg8::StaticOrder, true, true>(lds, g, S, E);
    }
    SEAM(6);
    if (IN(7)) { PH_IDS();
        pg8::Gemm g{(const bf16_t*)(ws + WS_ACT), (const bf16_t*)(ws + WS_WDN), SEQ, DM, DFF}; pg8::StaticOrder S; S.init(SEQ, DM, G, c);
        EpiDown E{0, (bf16_t*)(ws + WS_XB), (signed char*)(ws + WS_H2Q), ctl + CW_RSS1};
        pg8::gemm_phase<EpiDown, pg8::StaticOrder, true, true>(lds, g, S, E);
    }
    SEAM(7);
    if (IN(8)) { PH_IDS();
        pg8::Gemm g{(const bf16_t*)(ws + WS_H2Q), (const bf16_t*)(ws + WS_WG), SEQ, DM, DM}; pg8::StaticOrder S; S.init(SEQ, DM, G, c);
        EpiGate E{0, ap->out, (const bf16_t*)(ws + WS_XB), (const bf16_t*)(ws + WS_PP), ap->in[19], ctl + CW_RSS3, ctl + CW_RSS1, ctl + CW_CMAX_G};
        pg8::gemm_phase<EpiGate, pg8::StaticOrder, true, true>(lds, g, S, E);
    }
    SEAM(8);
    if (IN(9)) { PH_IDS(); ph_final_norm(ap->out, ctl + CW_RSS3, ap->in[21], gt, NGT); }
#undef IN
#undef SEAM
}

#ifndef MK_N_LAUNCHES
#define MK_N_LAUNCHES 1
#endif
extern "C" void kernel_launch(void* const* d_in, const int* in_sizes, int n_in, void* d_out, int out_size, void* d_ws, size_t ws_size, hipStream_t stream) {
    if (n_in != 22 || out_size != SEQ * DM || ws_size < WS_END) { fprintf(stderr, "kernel_launch: unexpected shapes (n_in %d out %d ws %zu)\n", n_in, out_size, ws_size); return; }
    unsigned char* ws = (unsigned char*)d_ws;
    static int grid = 0;
    if (grid == 0) {
        int dev = 0, cus = 0, per_cu = 0;
        (void)hipGetDevice(&dev); (void)hipDeviceGetAttribute(&cus, hipDeviceAttributeMultiprocessorCount, dev);
        (void)hipFuncSetAttribute((const void*)k_fwd, hipFuncAttributeMaxDynamicSharedMemorySize, LDS_BYTES);
        (void)hipOccupancyMaxActiveBlocksPerMultiprocessor(&per_cu, (const void*)k_fwd, 512, LDS_BYTES);
        if (per_cu < 1) fprintf(stderr, "kernel_launch: occupancy query says %d blocks per CU\n", per_cu);
        (void)hipGetLastError();
        grid = cus > 0 ? cus : 256;
    }
    (void)hipMemsetAsync(ws + WS_CTL, 0, CTL_ZERO_BYTES, stream);
    Args a; memset(&a, 0, sizeof(a)); for (int i = 0; i < 22; ++i) a.in[i] = (const float*)d_in[i]; a.out = (float*)d_out; a.ws = ws;
    if (MK_N_LAUNCHES == 1) { a.ph_lo = 0; a.ph_hi = N_PHASES; a.li = 0; hipLaunchKernelGGL(k_fwd, dim3(grid), dim3(512), LDS_BYTES, stream, a); }
    else for (int k = 0; k < N_PHASES; ++k) { a.ph_lo = k; a.ph_hi = k + 1; a.li = k; hipLaunchKernelGGL(k_fwd, dim3(grid), dim3(512), LDS_BYTES, stream, a); }
}
```

```cpp
#include <hip/hip_runtime.h>
#include <cstdio>
#include <cstdint>
#include <cstring>
namespace pg8 {
#define PG8_LAS __attribute__((address_space(3)))
typedef unsigned short bf16_t;
typedef short bf16x8 __attribute__((ext_vector_type(8)));
typedef float f32x4 __attribute__((ext_vector_type(4)));
typedef unsigned u32x4 __attribute__((ext_vector_type(4)));
typedef int i32x4 __attribute__((ext_vector_type(4)));
constexpr int BM = 256, BK = 64, HALF = 128, HTB = HALF * BK * 2  , STAGE_BYTES = 8 * HTB, NXCD = 8, WGM = 8;

__host__ __device__ __forceinline__ int lds_byte(int r, int c) { const int st = (r >> 4) * 2 + (c >> 5), rr = r & 15, cc = c & 31, ob = rr * 64 + cc * 2; return st * 1024 + (ob ^ (((ob >> 9) & 1) << 5)); }
__host__ __device__ __forceinline__ void stage_rc(int b, int& R, int& C) { const int st = b / 1024, sb = b % 1024, swz = sb ^ (((sb >> 9) & 1) << 5); R = (st >> 1) * 16 + swz / 64; C = (st & 1) * 32 + (swz % 64) / 2; }
__host__ __device__ __forceinline__ int perm32(int rho) { const int n = rho >> 4, i = rho & 15; return 8 * (i >> 2) + 4 * n + (i & 3); }

struct Unit { int pm, pn; };
struct Gemm { const bf16_t* A; const bf16_t* Bt; int M, N, K; size_t a_tstep = 0; };

struct StaticOrder {
    int nM, nN, nwg, G, c;
    __host__ __device__ void init(int M, int N, int G_, int c_) { nM = M / BM; nN = N / BM; nwg = nM * nN; G = G_; c = c_; }
    __host__ __device__ bool next(int i, Unit& u) const {
        const long L = (long)i * G + c; if (L >= nwg) return false;
        int wgid = (int)L; { const int q = nwg / NXCD, r = nwg % NXCD, xcd = wgid % NXCD, off = wgid / NXCD; wgid = (xcd < r ? xcd * (q + 1) : r * (q + 1) + (xcd - r) * q) + off; }
        const int nig = WGM * nN, gid = wgid / nig, fm = gid * WGM, gsz = (nM - fm) < WGM ? (nM - fm) : WGM;
        u.pm = fm + ((wgid % nig) % gsz); u.pn = (wgid % nig) / gsz; return true;
    }
    __device__ __forceinline__ void a_ready(const Unit&) const {}
    __device__ __forceinline__ void done(const Unit&) const {}
};
__device__ __forceinline__ unsigned cvt_pk_bf16(float lo, float hi) { unsigned r; asm volatile("v_cvt_pk_bf16_f32 %0, %1, %2" : "=v"(r) : "v"(lo), "v"(hi)); return r; }
template <class Epi, class Sched, bool ALIGN_EPI = false, bool SP2 = false>
__device__ __forceinline__ void gemm_phase(PG8_LAS unsigned char* lds, const Gemm g, const Sched& S, const Epi& E) {
    const int tid = threadIdx.x, wid = __builtin_amdgcn_readfirstlane(tid >> 6), lane = tid & 63, wr = wid >> 2, wc = wid & 3, fr = lane & 15, fq = lane >> 4;
    const int K = g.K, nt = Epi::I8 ? K / 128 : K / BK;
    unsigned voffA[2], voffB[2];
#pragma unroll
    for (int i = 0; i < 2; ++i) { int R, C; stage_rc(tid * 16 + i * 8192, R, C); const int Rb = Epi::PERM ? ((R & ~31) + perm32(R & 31)) : R;
        const int Ra = Epi::APERM ? ((R & ~63) | (4 * (R & 15) + ((R >> 4) & 3))) : R;
        voffA[i] = Epi::I8 ? (unsigned)(Ra * K + 2 * C) : (unsigned)(Ra * K + C) * 2u; voffB[i] = Epi::I8 ? (unsigned)(Rb * K + 2 * C) : (unsigned)(Rb * K + C) * 2u; }
    const size_t kstep = (size_t)(BK * 2);
    const size_t hstep = (size_t)HALF * K * (Epi::I8 ? 1 : 2);
    const size_t tstep = 2 * hstep;
    const size_t tstepA = g.a_tstep ? g.a_tstep : tstep;
    const unsigned ldsw = (unsigned)wid * 1024u;
    const int aoff = lds_byte(wr * 64 + fr, fq * 8), boff = lds_byte(wc * 32 + fr, fq * 8);
#define PG8_SA(b, h) (((b) * 2 + (h)) * HTB)
#define PG8_SB(b, h) ((4 + (b) * 2 + (h)) * HTB)
#define PG8_STAGE(bufoff, gbase, voff) do { _Pragma("unroll") for (int _i = 0; _i < 2; ++_i) \
        __builtin_amdgcn_global_load_lds((const unsigned*)((const char*)(gbase) + (voff)[_i]), (PG8_LAS unsigned*)(lds + (bufoff) + ldsw + _i * 8192), 16, 0, 0); } while (0)
#define PG8_LDA(dst, b, h) do { _Pragma("unroll") for (int m = 0; m < 4; ++m) _Pragma("unroll") for (int k = 0; k < 2; ++k) dst[m][k] = *(const PG8_LAS bf16x8*)(lds + PG8_SA(b, h) + aoff + m * 2048 + k * 1024); } while (0)
#define PG8_LDB(dst, b, h) do { _Pragma("unroll") for (int n = 0; n < 2; ++n) _Pragma("unroll") for (int k = 0; k < 2; ++k) dst[n][k] = *(const PG8_LAS bf16x8*)(lds + PG8_SB(b, h) + boff + n * 2048 + k * 1024); } while (0)
#define PG8_MMA(ai, bj, At, Bt) do { __builtin_amdgcn_s_setprio(1); _Pragma("unroll") for (int m = 0; m < 4; ++m) _Pragma("unroll") for (int n = 0; n < 2; ++n) _Pragma("unroll") for (int k = 0; k < 2; ++k) \
        { if constexpr (Epi::I8) acc[ai][bj][m][n] = __builtin_bit_cast(f32x4, __builtin_amdgcn_mfma_i32_16x16x64_i8(__builtin_bit_cast(i32x4, Bt[n][k]), __builtin_bit_cast(i32x4, At[m][k]), __builtin_bit_cast(i32x4, acc[ai][bj][m][n]), 0, 0, 0)); \
          else acc[ai][bj][m][n] = __builtin_amdgcn_mfma_f32_16x16x32_bf16(Bt[n][k], At[m][k], acc[ai][bj][m][n], 0, 0, 0); } __builtin_amdgcn_s_setprio(0); } while (0)
#define PG8_WAIT_V(n) asm volatile("s_waitcnt vmcnt(" #n ")" ::: "memory")
#define PG8_WAIT_L(n) asm volatile("s_waitcnt lgkmcnt(" #n ")" ::: "memory")
#define PG8_BAR __builtin_amdgcn_s_barrier()
#define PG8_SCHED __builtin_amdgcn_sched_barrier(0)
    Unit cur, nxt; int ui = 0;
    if (!S.next(0, cur)) return;
    f32x4 acc[2][2][4][2];
#pragma unroll
    for (int a = 0; a < 2; ++a)
#pragma unroll
        for (int b = 0; b < 2; ++b)
#pragma unroll
            for (int m = 0; m < 4; ++m)
#pragma unroll
                for (int n = 0; n < 2; ++n) acc[a][b][m][n] = (f32x4){0.f, 0.f, 0.f, 0.f};
    bf16x8 At[4][2], B0[2][2], B1[2][2];
    const char* cA = (const char*)g.A + (size_t)cur.pm * tstepA; const char* cB = (const char*)g.Bt + (size_t)cur.pn * tstep;
    S.a_ready(cur);
    if constexpr (SP2) {
        PG8_STAGE(PG8_SB(0, 0), cB, voffB); PG8_STAGE(PG8_SB(0, 1), cB + hstep, voffB); PG8_STAGE(PG8_SA(0, 0), cA, voffA); PG8_STAGE(PG8_SA(0, 1), cA + hstep, voffA);
        if (wr == 1) PG8_BAR;
        PG8_WAIT_V(2); PG8_BAR;
        PG8_STAGE(PG8_SB(1, 0), cB + kstep, voffB); PG8_STAGE(PG8_SA(1, 0), cA + kstep, voffA); PG8_STAGE(PG8_SB(1, 1), cB + hstep + kstep, voffB);
        PG8_WAIT_V(6); PG8_BAR;
    } else {
        PG8_STAGE(PG8_SB(0, 0), cB, voffB); PG8_STAGE(PG8_SA(0, 0), cA, voffA); PG8_STAGE(PG8_SB(0, 1), cB + hstep, voffB); PG8_STAGE(PG8_SA(0, 1), cA + hstep, voffA);
        if (wr == 1) PG8_BAR;
        PG8_WAIT_V(4); PG8_BAR;
        PG8_STAGE(PG8_SB(1, 0), cB + kstep, voffB); PG8_STAGE(PG8_SA(1, 0), cA + kstep, voffA); PG8_STAGE(PG8_SB(1, 1), cB + hstep + kstep, voffB);
        PG8_WAIT_V(6); PG8_BAR;
    }
    for (;;) {
        const bool has_next = S.next(ui + 1, nxt);
        const char* nA = has_next ? (const char*)g.A + (size_t)nxt.pm * tstepA : cA; const char* nB = has_next ? (const char*)g.Bt + (size_t)nxt.pn * tstep : cB;
        for (int t = 0; t < nt; t += 2) {
            const bool last = (t == nt - 2);
            const char* a1 = cA + (size_t)(t + 1) * kstep;
            const char* a2 = last ? nA : cA + (size_t)(t + 2) * kstep; const char* b2 = last ? nB : cB + (size_t)(t + 2) * kstep;
            const char* a3 = a2 + kstep; const char* b3 = b2 + kstep;
            if (last && has_next) S.a_ready(nxt);
            if constexpr (Epi::HAS_MID) { if (t == E.tmid) E.mid(acc, cur, wr, fr); }
            if constexpr (SP2) {
            PG8_LDB(B0, 0, 0); PG8_LDB(B1, 0, 1); PG8_SCHED; PG8_LDA(At, 0, 0); PG8_STAGE(PG8_SA(1, 1), a1 + hstep, voffA);
            PG8_WAIT_V(8); PG8_WAIT_L(0); PG8_BAR; PG8_MMA(0, 0, At, B0); PG8_MMA(0, 1, At, B1); PG8_BAR; PG8_SCHED;
            PG8_LDA(At, 0, 1); PG8_STAGE(PG8_SB(0, 0), b2, voffB); PG8_STAGE(PG8_SB(0, 1), b2 + hstep, voffB); PG8_STAGE(PG8_SA(0, 0), a2, voffA);
            PG8_WAIT_V(8); PG8_WAIT_L(0); PG8_BAR; PG8_MMA(1, 0, At, B0); PG8_MMA(1, 1, At, B1); PG8_BAR; PG8_SCHED;
            PG8_LDB(B0, 1, 0); PG8_LDB(B1, 1, 1); PG8_SCHED; PG8_LDA(At, 1, 0); PG8_STAGE(PG8_SA(0, 1), a2 + hstep, voffA);
            PG8_WAIT_V(8); PG8_WAIT_L(0); PG8_BAR; PG8_MMA(0, 0, At, B0); PG8_MMA(0, 1, At, B1); PG8_BAR; PG8_SCHED;
            PG8_LDA(At, 1, 1); PG8_STAGE(PG8_SB(1, 0), b3, voffB); PG8_STAGE(PG8_SB(1, 1), b3 + hstep, voffB); PG8_STAGE(PG8_SA(1, 0), a3, voffA);
            PG8_WAIT_V(8); PG8_WAIT_L(0); PG8_BAR; PG8_MMA(1, 0, At, B0); PG8_MMA(1, 1, At, B1); PG8_BAR; PG8_SCHED;
            } else {
            PG8_LDB(B0, 0, 0); PG8_SCHED; PG8_LDA(At, 0, 0); PG8_STAGE(PG8_SA(1, 1), a1 + hstep, voffA);
            PG8_WAIT_L(8); PG8_BAR; PG8_WAIT_L(0); PG8_MMA(0, 0, At, B0); PG8_BAR; PG8_SCHED;
            PG8_LDB(B1, 0, 1); PG8_STAGE(PG8_SB(0, 0), b2, voffB);
            PG8_BAR; PG8_WAIT_L(0); PG8_MMA(0, 1, At, B1); PG8_BAR;
            PG8_LDA(At, 0, 1); PG8_STAGE(PG8_SA(0, 0), a2, voffA);
            PG8_BAR; PG8_WAIT_L(0); PG8_MMA(1, 0, At, B0); PG8_BAR; PG8_SCHED;
            PG8_STAGE(PG8_SB(0, 1), b2 + hstep, voffB);
            PG8_WAIT_V(6); PG8_BAR; PG8_MMA(1, 1, At, B1); PG8_BAR;
            PG8_LDB(B0, 1, 0); PG8_SCHED; PG8_LDA(At, 1, 0); PG8_STAGE(PG8_SA(0, 1), a2 + hstep, voffA);
            PG8_WAIT_L(8); PG8_BAR; PG8_WAIT_L(0); PG8_MMA(0, 0, At, B0); PG8_BAR; PG8_SCHED;
            PG8_LDB(B1, 1, 1); PG8_STAGE(PG8_SB(1, 0), b3, voffB);
            PG8_BAR; PG8_WAIT_L(0); PG8_MMA(0, 1, At, B1); PG8_BAR;
            PG8_LDA(At, 1, 1); PG8_STAGE(PG8_SA(1, 0), a3, voffA);
            PG8_BAR; PG8_WAIT_L(0); PG8_MMA(1, 0, At, B0); PG8_BAR; PG8_SCHED;
            PG8_STAGE(PG8_SB(1, 1), b3 + hstep, voffB);
            PG8_WAIT_V(6); PG8_BAR; PG8_MMA(1, 1, At, B1); PG8_BAR;
            }
        }
        if constexpr (ALIGN_EPI) { if (wr == 0) PG8_BAR; }
        if constexpr (!Epi::AFTER_DRAIN) { E(acc, cur, wr, wc, fr, fq); S.done(cur); }
        if (!has_next) break;
#pragma unroll
        for (int a = 0; a < 2; ++a)
#pragma unroll
            for (int b = 0; b < 2; ++b)
#pragma unroll
                for (int m = 0; m < 4; ++m)
#pragma unroll
                    for (int n = 0; n < 2; ++n) acc[a][b][m][n] = (f32x4){0.f, 0.f, 0.f, 0.f};
        cur = nxt; cA = nA; cB = nB; ++ui;
        if constexpr (ALIGN_EPI) { if (wr == 1) PG8_BAR; }
    }
    PG8_WAIT_V(0);
    if constexpr (!ALIGN_EPI) { if (wr == 0) PG8_BAR; }
    PG8_BAR;
    if constexpr (Epi::AFTER_DRAIN) { E.fused(acc, cur, wr, wc, fr, fq, lds, wid, lane); S.done(cur); }
#undef PG8_SA
#undef PG8_SB
#undef PG8_STAGE
#undef PG8_LDA
#undef PG8_LDB
#undef PG8_MMA
#undef PG8_WAIT_V
#undef PG8_WAIT_L
#undef PG8_BAR
#undef PG8_SCHED
}
}

constexpr int SEQ = 16384, DM = 4096;
constexpr int NQH = 32, NKVH = 4, HD = 64;
constexpr int DSSM = 2048, NSH = 32, SSTATE = 128, SGRP = 8;
constexpr int XBCC = 4096, NPROJ = 8736, NPROJ_PAD = 8960;
constexpr int DFF = 11008, PLE = 256;
constexpr float EPS = 1e-6f;

typedef unsigned short bf16_t;
using pg8::f32x4; using pg8::u32x4; using pg8::cvt_pk_bf16;
typedef unsigned u32x2 __attribute__((ext_vector_type(2)));
#define LAS __attribute__((address_space(3)))

__device__ __forceinline__ float bf2f(unsigned b) { return __uint_as_float(b << 16); }
__device__ __forceinline__ u32x4 pack8(const f32x4 a, const f32x4 b) { u32x4 w; w.x = cvt_pk_bf16(a[0], a[1]); w.y = cvt_pk_bf16(a[2], a[3]); w.z = cvt_pk_bf16(b[0], b[1]); w.w = cvt_pk_bf16(b[2], b[3]); return w; }
__device__ __forceinline__ u32x2 pack4(const f32x4 a) { u32x2 w; w.x = cvt_pk_bf16(a[0], a[1]); w.y = cvt_pk_bf16(a[2], a[3]); return w; }
__device__ __forceinline__ void unpack8(const u32x4 w, float (&o)[8]) {
    o[0] = bf2f(w.x & 0xffffu); o[1] = __uint_as_float(w.x & 0xffff0000u); o[2] = bf2f(w.y & 0xffffu); o[3] = __uint_as_float(w.y & 0xffff0000u);
    o[4] = bf2f(w.z & 0xffffu); o[5] = __uint_as_float(w.z & 0xffff0000u); o[6] = bf2f(w.w & 0xffffu); o[7] = __uint_as_float(w.w & 0xffff0000u); }
__device__ __forceinline__ float silu_f(float x) { return x * __builtin_amdgcn_rcpf(1.f + __expf(-x)); }
__device__ __forceinline__ float sigm_f(float x) { return __builtin_amdgcn_rcpf(1.f + __expf(-x)); }
__device__ __forceinline__ float softplus_f(float x) { return x > 20.f ? x : log1pf(expf(x)); }
__device__ __forceinline__ float wave_sum(float v) {
#pragma unroll
    for (int o = 1; o < 64; o <<= 1) v += __shfl_xor(v, o);
    return v;
}

constexpr size_t MiB = 1u << 20;
constexpr size_t WS_CTL = 0, CTL_ZERO_BYTES = 1 * MiB;
constexpr size_t WS_RS0 = 1 * MiB;
constexpr size_t WS_COS = 2 * MiB, WS_SIN = 4 * MiB;
constexpr size_t WS_DT = 6 * MiB;
constexpr size_t WS_WIN = 8 * MiB;
constexpr size_t WS_WO = 78 * MiB;
constexpr size_t WS_WUP = 110 * MiB;
constexpr size_t WS_WDN = 282 * MiB;
constexpr size_t WS_WG = 368 * MiB;
constexpr size_t WS_WP = 400 * MiB;
constexpr size_t WS_PB = 402 * MiB;
constexpr size_t WS_XB = 410 * MiB;
constexpr size_t WS_MIX = 538 * MiB;
constexpr size_t WS_Y = 666 * MiB;
constexpr size_t WS_PP = 1226 * MiB;
constexpr size_t WS_U = 538 * MiB;
constexpr size_t WS_Q = 794 * MiB;
constexpr size_t WS_K = 858 * MiB;
constexpr size_t WS_V = 866 * MiB;
constexpr size_t WS_Z = 874 * MiB;
constexpr size_t WS_XBC = 938 * MiB;
constexpr size_t WS_XACT = 1066 * MiB;
constexpr size_t WS_ACT = 882 * MiB;
constexpr size_t WS_H1Q = WS_Y, WS_H2Q = WS_MIX;
constexpr size_t WS_END = 1354 * MiB;
constexpr int CW_BAR = 4096;
constexpr int CW_CMAX_UP = 131072, CW_CMAX_G = 131072 + 22016;
constexpr float QCLIP = 4.5f;
constexpr int CW_RSS_SSM = 65536, CW_RSS1 = 65536 + 16384, CW_RSS3 = 65536 + 32768;

#define XB_TMO      128
#define XB_XCNT(j)  (256  + 64 * (j))
#define XB_XSUB(j)  (1280 + 64 * (j))
#define XB_XGEN(j)  (2304 + 64 * (j))
#define XB_TOP      3328
#define XB_TOPGEN   3392
#define XCD_BAR_WORDS 3456
#define XB_SPIN_CAP (1u << 18)

__device__ __forceinline__ unsigned xb_ld(unsigned* p)              { return __hip_atomic_load(p, __ATOMIC_RELAXED, __HIP_MEMORY_SCOPE_AGENT); }
__device__ __forceinline__ unsigned xb_add(unsigned* p, unsigned v) { return __hip_atomic_fetch_add(p, v, __ATOMIC_RELAXED, __HIP_MEMORY_SCOPE_AGENT); }
__device__ __forceinline__ unsigned xb_xcc_id() { return (unsigned)__builtin_amdgcn_s_getreg((3 << 11) | 20) & 0xFu; }
#define XB_SPIN(cond, bar) do { unsigned _sp = 0; while (cond) { __builtin_amdgcn_s_sleep(1); \
    if ((++_sp & 255u) == 0u) { if (xb_ld(&(bar)[XB_TMO])) break; if (_sp > XB_SPIN_CAP) { atomicAdd(&(bar)[XB_TMO], 1u); break; } } } } while (0)

struct XcdBarrier {
    unsigned* bar; unsigned x;
    volatile LAS unsigned* st;
};

__device__ __forceinline__ XcdBarrier xcd_barrier_post(unsigned* bar, volatile LAS unsigned* st) {
    XcdBarrier b; b.bar = bar; b.x = xb_xcc_id(); b.st = st;
    if (threadIdx.x == 0) (void)xb_add(&bar[XB_XCNT(b.x)], 1u);
    return b;
}
__device__ __forceinline__ void xcd_barrier_complete(unsigned* bar, unsigned x, unsigned& nloc, unsigned& nx) {
    const unsigned G = gridDim.x * gridDim.y * gridDim.z;
    unsigned sum, cnt, mine, sp = 0u;
    for (;;) {
        sum = 0u; cnt = 0u; mine = 0u;
#pragma unroll
        for (unsigned j = 0; j < 16; ++j) { const unsigned c = xb_ld(&bar[XB_XCNT(j)]); sum += c; cnt += (c > 0u) ? 1u : 0u; mine = (j == x) ? c : mine; }
        if (sum == G) break;
        __builtin_amdgcn_s_sleep(1);
        if ((++sp & 255u) == 0u) { if (xb_ld(&bar[XB_TMO])) break; if (sp > XB_SPIN_CAP) { atomicAdd(&bar[XB_TMO], 1u); break; } }
    }
    nloc = mine > 0u ? mine : 1u; nx = cnt > 0u ? cnt : 1u;
}

__device__ __forceinline__ void xcd_barrier(const XcdBarrier& b) {
    asm volatile("s_waitcnt vmcnt(0)" ::: "memory");
    __syncthreads();
    if (threadIdx.x == 0) {
        unsigned* bar = b.bar;
        __builtin_amdgcn_s_waitcnt(0);
        unsigned nloc = b.st[0], nx = b.st[1];
        if (nloc == 0u) { xcd_barrier_complete(bar, b.x, nloc, nx); b.st[0] = nloc; b.st[1] = nx; }
        const unsigned old = xb_add(&bar[XB_XSUB(b.x)], 1u);
        const unsigned gen = old / nloc;
        if (old + 1u == (gen + 1u) * nloc) {
            __builtin_amdgcn_fence(__ATOMIC_RELEASE, "agent");
            asm volatile("s_waitcnt vmcnt(0)" ::: "memory");
            const unsigned og = xb_add(&bar[XB_TOP], 1u);
            const unsigned tg = og / nx;
            if (og + 1u == (tg + 1u) * nx) xb_add(&bar[XB_TOPGEN], 1u);
            else XB_SPIN(xb_ld(&bar[XB_TOPGEN]) == tg, bar);
            __builtin_amdgcn_fence(__ATOMIC_ACQUIRE, "agent");
            xb_add(&bar[XB_XGEN(b.x)], 1u);
            asm volatile("s_waitcnt vmcnt(0)" ::: "memory");
        } else {
            XB_SPIN(xb_ld(&bar[XB_XGEN(b.x)]) == gen, bar);
            __builtin_amdgcn_fence(__ATOMIC_ACQUIRE, "agent");
            asm volatile("s_waitcnt vmcnt(0)" ::: "memory");
        }
    }
    __syncthreads();
}
__device__ __forceinline__ int cperm(int p) { return (p & 0xE0) | (((p >> 2) & 3) << 3) | (((p >> 4) & 1) << 2) | (p & 3); }
__device__ __forceinline__ int colmap(int kind, int row) {
    const int tile = row >> 8, p = row & 255;
    if (kind == 0) return (tile << 8) | cperm(p);
    if (kind == 1) {
        if (tile < 9) { const int bj = p >> 7, wc = (p >> 5) & 3, n = (p >> 4) & 1, fq = (p >> 2) & 3, j = p & 3;
            return tile * 256 + (2 * bj + (wc >> 1)) * 64 + 32 * n + 16 * (wc & 1) + 4 * fq + j; }
        if (tile < 34) return (tile << 8) | cperm(p);
        const int c = cperm(p); return c < 32 ? 8704 + c : -1;
    }
    { const int bj = p >> 7, cc = cperm(p) & 127; return bj * DFF + tile * 128 + cc; }
}
__device__ __forceinline__ int srcbase_of(int kind, int r0) {
    if (kind == 2) { const int pn = r0 >> 8, q64 = (r0 >> 6) & 3; return (q64 >> 1) * DFF + pn * 128 + (q64 & 1) * 64; }
    return r0;
}
struct TrJob { const float* W; bf16_t* WT; const float* kscale; const float* qmax; int K, N, nrows, kind, kxor, kscale_n, pad; };
__device__ __forceinline__ void ph_transpose(const TrJob job, LAS unsigned* scr, int gw, int NGW, int lane) {
    const float* __restrict__ W = job.W; bf16_t* __restrict__ WT = job.WT; const float* __restrict__ ks = job.kscale;
    const int ngrp = job.nrows / 64, nitems = (job.K / 64) * ngrp;
    for (int item = gw; item < nitems; item += NGW) {
        const int kb = item / ngrp, gq = item % ngrp, k0 = 64 * kb, r0 = 64 * gq, sb = srcbase_of(job.kind, r0);
        const int n4 = (lane & 15) * 4; const bool inb = sb + n4 < job.N;
        f32x4 v[8][2];
#pragma unroll
        for (int i = 0; i < 8; ++i) { const int kp = 4 * i + (lane >> 4);
#pragma unroll
            for (int q = 0; q < 2; ++q) { const int k = k0 + 2 * kp + q; f32x4 t = {0.f, 0.f, 0.f, 0.f};
                if (inb) t = *(const f32x4*)(W + (size_t)(k ^ job.kxor) * job.N + sb + n4);
                v[i][q] = t; } }
        asm volatile("" ::: "memory");
        if (ks) { float kv[8][2];
#pragma unroll
            for (int i = 0; i < 8; ++i) { const int kp = 4 * i + (lane >> 4);
#pragma unroll
                for (int q = 0; q < 2; ++q) { const int k = k0 + 2 * kp + q; kv[i][q] = k < job.kscale_n ? ks[k] : 1.f; } }
#pragma unroll
            for (int i = 0; i < 8; ++i)
#pragma unroll
                for (int q = 0; q < 2; ++q) v[i][q] = v[i][q] * kv[i][q]; }
#pragma unroll
        for (int i = 0; i < 8; ++i) { const int kp = 4 * i + (lane >> 4);
#pragma unroll
            for (int e = 0; e < 4; ++e) scr[kp * 65 + n4 + e] = cvt_pk_bf16(v[i][0][e], v[i][1][e]); }
        asm volatile("s_waitcnt lgkmcnt(0)" ::: "memory");
        const int c = lane & 7;
#pragma unroll
        for (int j = 0; j < 8; ++j) { const int n = (lane >> 3) + 8 * j; const int sc = colmap(job.kind, r0 + n) - sb;
            u32x4 o = {0u, 0u, 0u, 0u};
            if (sc >= 0) { o.x = scr[(4 * c + 0) * 65 + sc]; o.y = scr[(4 * c + 1) * 65 + sc]; o.z = scr[(4 * c + 2) * 65 + sc]; o.w = scr[(4 * c + 3) * 65 + sc]; }
            *(u32x4*)(WT + (size_t)(r0 + n) * job.K + k0 + 8 * c) = o; }
        asm volatile("s_waitcnt lgkmcnt(0)" ::: "memory");
    }
}
__device__ __forceinline__ void ph_xprep(const float* __restrict__ x, bf16_t* __restrict__ xb, float* __restrict__ rs0, int gw, int NGW, int lane) {
    for (int t = gw; t < SEQ; t += NGW) {
        const f32x4* xr = (const f32x4*)(x + (size_t)t * DM); f32x4 a[8], b[8]; float ss = 0.f;
#pragma unroll
        for (int i = 0; i < 8; ++i) { a[i] = xr[(i * 64 + lane) * 2]; b[i] = xr[(i * 64 + lane) * 2 + 1]; }
#pragma unroll
        for (int i = 0; i < 8; ++i) { ss += (a[i][0] * a[i][0] + a[i][1] * a[i][1]) + (a[i][2] * a[i][2] + a[i][3] * a[i][3]) + (b[i][0] * b[i][0] + b[i][1] * b[i][1]) + (b[i][2] * b[i][2] + b[i][3] * b[i][3]);
            *(u32x4*)(xb + (size_t)t * DM + (i * 64 + lane) * 8) = pack8(a[i], b[i]); }
        ss = wave_sum(ss);
        if (lane == 0) rs0[t] = rsqrtf(ss * (1.f / DM) + EPS);
    }
}
__device__ __forceinline__ void ph_pprep(const float* __restrict__ p, bf16_t* __restrict__ pb, size_t gt, size_t NGT) {
    const size_t n8 = (size_t)SEQ * PLE / 8;
    for (size_t i = gt; i < n8; i += NGT) {
        const f32x4 a = ((const f32x4*)p)[2 * i], b = ((const f32x4*)p)[2 * i + 1]; ((u32x4*)pb)[i] = pack8(a, b); }
}
__device__ __forceinline__ void ph_trig(const int* __restrict__ positions, float* __restrict__ cosT, float* __restrict__ sinT, size_t gt, size_t NGT) {
  for (size_t ii = gt; ii < (size_t)SEQ * 32; ii += NGT) { const int i = (int)ii;
    const int t = i >> 5, f = i & 31;
    const float invf = powf(10000.f, -(float)f / 32.f);
    const float ang = (float)positions[t] * invf;
    float s, c; sincosf(ang, &s, &c); cosT[i] = c; sinT[i] = s; }
}
__device__ __forceinline__ void ph_convglu(const bf16_t* __restrict__ U, const float* __restrict__ cw, const float* __restrict__ cb, bf16_t* __restrict__ ACT, int half, size_t gt, size_t NGT) {
    const size_t nitems = (size_t)688 * (SEQ / 16);
    for (size_t it = gt; it < nitems; it += NGT) {
        const int cgi = (int)(it % 688), seg = (int)(it / 688), pl = cgi >> 4, cc = (cgi & 15) * 8, c0 = (half * 43 + pl) * 128 + cc, t0 = seg * 16;
        float wg[3][8], wu[3][8], bg[8], bu[8];
#pragma unroll
        for (int k = 0; k < 3; ++k) { const f32x4 g0 = *(const f32x4*)(cw + (size_t)k * 2 * DFF + c0), g1 = *(const f32x4*)(cw + (size_t)k * 2 * DFF + c0 + 4), u0 = *(const f32x4*)(cw + (size_t)k * 2 * DFF + DFF + c0), u1 = *(const f32x4*)(cw + (size_t)k * 2 * DFF + DFF + c0 + 4);
#pragma unroll
            for (int e = 0; e < 4; ++e) { wg[k][e] = g0[e]; wg[k][4 + e] = g1[e]; wu[k][e] = u0[e]; wu[k][4 + e] = u1[e]; } }
        { const f32x4 g0 = *(const f32x4*)(cb + c0), g1 = *(const f32x4*)(cb + c0 + 4), u0 = *(const f32x4*)(cb + DFF + c0), u1 = *(const f32x4*)(cb + DFF + c0 + 4);
#pragma unroll
          for (int e = 0; e < 4; ++e) { bg[e] = g0[e]; bg[4 + e] = g1[e]; bu[e] = u0[e]; bu[4 + e] = u1[e]; } }
        u32x4 rg[18], ru[18];
#pragma unroll
        for (int i = 0; i < 18; ++i) { const int tt = t0 - 2 + i;
            if (tt >= 0) { rg[i] = *(const u32x4*)(U + (size_t)tt * DFF + pl * 256 + cc); ru[i] = *(const u32x4*)(U + (size_t)tt * DFF + pl * 256 + 128 + cc); }
            else { rg[i] = (u32x4){0u, 0u, 0u, 0u}; ru[i] = (u32x4){0u, 0u, 0u, 0u}; } }
        float g2[8], g1v[8], u2[8], u1v[8];
        unpack8(rg[0], g2); unpack8(rg[1], g1v); unpack8(ru[0], u2); unpack8(ru[1], u1v);
#pragma unroll
        for (int i = 0; i < 16; ++i) { float gv[8], uv[8]; unpack8(rg[i + 2], gv); unpack8(ru[i + 2], uv); float o[8];
#pragma unroll
            for (int e = 0; e < 8; ++e) { const float g = bg[e] + wg[0][e] * g2[e] + wg[1][e] * g1v[e] + wg[2][e] * gv[e], u = bu[e] + wu[0][e] * u2[e] + wu[1][e] * u1v[e] + wu[2][e] * uv[e];
                o[e] = silu_f(g) * u; g2[e] = g1v[e]; g1v[e] = gv[e]; u2[e] = u1v[e]; u1v[e] = uv[e]; }
            u32x4 w; w.x = cvt_pk_bf16(o[0], o[1]); w.y = cvt_pk_bf16(o[2], o[3]); w.z = cvt_pk_bf16(o[4], o[5]); w.w = cvt_pk_bf16(o[6], o[7]);
            *(u32x4*)(ACT + (size_t)(t0 + i) * DFF + c0) = w; }
    }
}
__device__ __forceinline__ void ph_final_norm(float* H, const float* __restrict__ rowss, const float* __restrict__ g, size_t gt, size_t NGT) {
    const size_t n4 = (size_t)SEQ * DM / 4;
    f32x4* h4 = (f32x4*)H;
    for (size_t i0 = gt; i0 < n4; i0 += 8 * NGT) {
        f32x4 v[8]; float rs[8];
#pragma unroll
        for (int k = 0; k < 8; ++k) { const size_t i = i0 + k * NGT; v[k] = h4[i]; rs[k] = rowss[i >> 10]; }
#pragma unroll
        for (int k = 0; k < 8; ++k) { const size_t i = i0 + k * NGT; const f32x4 gg = ((const f32x4*)g)[i & 1023]; h4[i] = v[k] * rsqrtf(rs[k] * (1.f / DM) + EPS) * gg; }
    }
}

constexpr float CMAX_SAFE = 1.1f;
__device__ __forceinline__ void ph_colmax(const float* __restrict__ W, const float* __restrict__ g, int K, int N, unsigned* cmax, int gw, int NGW, int lane) {
    const int ncb = N / 256, nitems = (K / 64) * ncb;
    for (int item = gw; item < nitems; item += NGW) { const int kb = item / ncb, cb = item % ncb, col = cb * 256 + lane * 4;
        f32x4 m = {0.f, 0.f, 0.f, 0.f};
        f32x4 v[16];
#pragma unroll
        for (int kk = 0; kk < 16; ++kk) v[kk] = *(const f32x4*)(W + (size_t)(kb * 64 + 4 * kk) * N + col);
#pragma unroll
        for (int kk = 0; kk < 16; ++kk) { const float gg = g ? g[kb * 64 + 4 * kk] : 1.f;
#pragma unroll
            for (int e = 0; e < 4; ++e) m[e] = fmaxf(m[e], fabsf(v[kk][e] * gg)); }
#pragma unroll
        for (int e = 0; e < 4; ++e) atomicMax(cmax + col + e, __float_as_uint(m[e] * CMAX_SAFE)); }
}

__device__ __forceinline__ void ph_transpose_q8(const TrJob job, LAS unsigned* scr, int gw, int NGW, int lane) {
    const float* __restrict__ W = job.W; signed char* __restrict__ WQ = (signed char*)job.WT; const float* __restrict__ ks = job.kscale;
    const int ngrp = job.nrows / 64, nitems = (job.K / 64) * ngrp;
    for (int item = gw; item < nitems; item += NGW) {
        const int kb = item / ngrp, gq = item % ngrp, k0 = 64 * kb, r0 = 64 * gq, sb = srcbase_of(job.kind, r0);
        const int n4 = (lane & 15) * 4; const bool inb = sb + n4 < job.N;
        f32x4 isc = {0.f, 0.f, 0.f, 0.f};
        if (inb) { const f32x4 cm = *(const f32x4*)(job.qmax + sb + n4);
#pragma unroll
            for (int e = 0; e < 4; ++e) isc[e] = cm[e] > 0.f ? 127.f / cm[e] : 0.f; }
        f32x4 v[4][4];
#pragma unroll
        for (int i = 0; i < 4; ++i) { const int kq = 4 * i + (lane >> 4);
#pragma unroll
            for (int q = 0; q < 4; ++q) { const int k = k0 + 4 * kq + q; f32x4 t = {0.f, 0.f, 0.f, 0.f};
                if (inb) t = *(const f32x4*)(W + (size_t)k * job.N + sb + n4);
                v[i][q] = t; } }
        asm volatile("" ::: "memory");
        { float kv[4][4];
#pragma unroll
          for (int i = 0; i < 4; ++i) { const int kq = 4 * i + (lane >> 4);
#pragma unroll
              for (int q = 0; q < 4; ++q) { const int k = k0 + 4 * kq + q; kv[i][q] = (ks && k < job.kscale_n) ? ks[k] : 1.f; } }
#pragma unroll
          for (int i = 0; i < 4; ++i)
#pragma unroll
              for (int q = 0; q < 4; ++q) v[i][q] = v[i][q] * isc * kv[i][q]; }
#pragma unroll
        for (int i = 0; i < 4; ++i) { const int kq = 4 * i + (lane >> 4);
#pragma unroll
            for (int e = 0; e < 4; ++e) { const int b0 = (int)rintf(fminf(fmaxf(v[i][0][e], -127.f), 127.f)), b1 = (int)rintf(fminf(fmaxf(v[i][1][e], -127.f), 127.f)), b2 = (int)rintf(fminf(fmaxf(v[i][2][e], -127.f), 127.f)), b3 = (int)rintf(fminf(fmaxf(v[i][3][e], -127.f), 127.f));
                scr[kq * 65 + n4 + e] = (unsigned)(b0 & 255) | ((unsigned)(b1 & 255) << 8) | ((unsigned)(b2 & 255) << 16) | ((unsigned)b3 << 24); } }
        asm volatile("s_waitcnt lgkmcnt(0)" ::: "memory");
        const int c = lane & 3;
#pragma unroll
        for (int j = 0; j < 4; ++j) { const int n = (lane >> 2) + 16 * j; const int sc = colmap(job.kind, r0 + n) - sb;
            u32x4 o = {0u, 0u, 0u, 0u};
            if (sc >= 0) { o.x = scr[(4 * c + 0) * 65 + sc]; o.y = scr[(4 * c + 1) * 65 + sc]; o.z = scr[(4 * c + 2) * 65 + sc]; o.w = scr[(4 * c + 3) * 65 + sc]; }
            *(u32x4*)(WQ + (size_t)(r0 + n) * job.K + k0 + 16 * c) = o; }
        asm volatile("s_waitcnt lgkmcnt(0)" ::: "memory");
    }
}
typedef float f32x16 __attribute__((ext_vector_type(16)));
typedef short bf16x8 __attribute__((ext_vector_type(8)));
typedef short s16x4 __attribute__((ext_vector_type(4)));
#define MFMA32(a, b, c) __builtin_amdgcn_mfma_f32_32x32x16_bf16((a), (b), (c), 0, 0, 0)
constexpr int SSD_XT = 0, SSD_BT = 65536, SSD_CT = 98304, SSD_DT = 132096, SSD_ACS = SSD_DT + 2048;
constexpr size_t WS_STATES = WS_Y, WS_PREV = WS_XACT, WS_CDEC = WS_RS0 + 65536;

__device__ __forceinline__ unsigned off_b(unsigned row, unsigned ch) { return 256u * row + 16u * (ch ^ (((row & 3) << 2) | ((row >> 2) & 3))); }
__device__ __forceinline__ bf16x8 lds_row8(LAS const unsigned char* tile, unsigned row, unsigned ch) { return *(LAS const bf16x8*)(tile + off_b(row, ch)); }
__device__ __forceinline__ s16x4 lds_tr4(LAS const unsigned char* tile, unsigned rowbase, unsigned c32, unsigned lane) {
    const unsigned blk = (lane >> 4) & 1, q = (lane & 15) >> 2, p = lane & 3;
    LAS const unsigned char* a = tile + off_b(rowbase + q, 4 * c32 + 2 * blk + (p >> 1)) + 8 * (p & 1);
    return __builtin_bit_cast(s16x4, __builtin_amdgcn_ds_read_tr16_b64_v4i16((LAS s16x4*)a));
}
__device__ __forceinline__ bf16x8 cat4(const s16x4 a, const s16x4 b) { return __builtin_shufflevector(a, b, 0, 1, 2, 3, 4, 5, 6, 7); }
__device__ __forceinline__ float bfs2f(short s) { return __uint_as_float(((unsigned)(unsigned short)s) << 16); }

template <bool NEED_C>
__device__ __forceinline__ void ssd_stage(LAS unsigned char* lds, const bf16_t* XBC, const float* cw, const float* cb, const float* DT, const float* a_log, int c, int g, int tid, int lane, int wave) {
    {
        const int cgi = tid & 63, seg = tid >> 6;
        int col, tch; LAS unsigned char* tile;
        if (cgi < 32) { col = g * 256 + cgi * 8; tile = lds + SSD_XT + (cgi >> 4) * 32768; tch = cgi & 15; }
        else if (cgi < 48) { col = 2048 + g * 128 + (cgi - 32) * 8; tile = lds + SSD_BT; tch = cgi - 32; }
        else { col = 3072 + g * 128 + (cgi - 48) * 8; tile = lds + SSD_CT; tch = cgi - 48; }
        if (NEED_C || cgi < 48) {
            float w[4][8], b[8], xw[3][8];
#pragma unroll
            for (int k = 0; k < 4; ++k) { const f32x4 w0 = *(const f32x4*)(cw + k * XBCC + col), w1 = *(const f32x4*)(cw + k * XBCC + col + 4);
#pragma unroll
                for (int e = 0; e < 4; ++e) { w[k][e] = w0[e]; w[k][4 + e] = w1[e]; } }
            { const f32x4 b0 = *(const f32x4*)(cb + col), b1 = *(const f32x4*)(cb + col + 4);
#pragma unroll
              for (int e = 0; e < 4; ++e) { b[e] = b0[e]; b[4 + e] = b1[e]; } }
            const int t0 = c * 128 + seg * 16;
            u32x4 raw[19];
#pragma unroll
            for (int k = 0; k < 19; ++k) { const int tt = t0 - 3 + k;
                if (k >= 3 || tt >= 0) raw[k] = *(const u32x4*)(XBC + (size_t)tt * XBCC + col);
                else raw[k] = (u32x4){0u, 0u, 0u, 0u}; }
            asm volatile("" ::: "memory");
#pragma unroll
            for (int k = 0; k < 3; ++k) unpack8(raw[k], xw[k]);
#pragma unroll
            for (int i = 0; i < 16; ++i) { float xv[8]; unpack8(raw[3 + i], xv);
                float o[8];
#pragma unroll
                for (int e = 0; e < 8; ++e) { o[e] = silu_f(b[e] + w[0][e] * xw[0][e] + w[1][e] * xw[1][e] + w[2][e] * xw[2][e] + w[3][e] * xv[e]); xw[0][e] = xw[1][e]; xw[1][e] = xw[2][e]; xw[2][e] = xv[e]; }
                u32x4 pk; pk.x = cvt_pk_bf16(o[0], o[1]); pk.y = cvt_pk_bf16(o[2], o[3]); pk.z = cvt_pk_bf16(o[4], o[5]); pk.w = cvt_pk_bf16(o[6], o[7]);
                *(LAS u32x4*)(tile + off_b(seg * 16 + i, tch)) = pk; }
        }
    }
    { const int l = tid >> 2, r = tid & 3, hd = 4 * g + r; const float dtv = DT[(size_t)(c * 128 + l) * 32 + hd]; const float a = -expf(a_log[hd]);
      ((LAS float*)(lds + SSD_DT))[r * 128 + l] = dtv; ((LAS float*)(lds + SSD_ACS))[r * 128 + l] = dtv * a; }
    __syncthreads();
    if (wave < 4) { LAS float* ac = (LAS float*)(lds + SSD_ACS) + wave * 128; const float v0 = ac[2 * lane], v1 = ac[2 * lane + 1]; const float s = v0 + v1; float inc = s;
#pragma unroll
        for (int o = 1; o < 64; o <<= 1) { const float t = __shfl_up(inc, o); if (lane >= o) inc += t; }
        ac[2 * lane] = inc - s + v0; ac[2 * lane + 1] = inc; }
    __syncthreads();
}

__device__ __forceinline__ void ssd_pass1_unit(LAS unsigned char* lds, float* STATES, float* CDEC, int c, int g, int lane, int wave) {
    const int r = wave >> 1, nh = wave & 1, h = lane >> 5, hd = 4 * g + r;
    LAS const unsigned char* xt = lds + SSD_XT + (r >> 1) * 32768; const unsigned xc = 2 * (r & 1);
    LAS const unsigned char* bt = lds + SSD_BT;
    LAS const float* dtl = (LAS const float*)(lds + SSD_DT) + r * 128; LAS const float* acs = (LAS const float*)(lds + SSD_ACS) + r * 128;
    const float alast = acs[127];
    f32x16 acc[2][2];
#pragma unroll
    for (int i = 0; i < 2; ++i)
#pragma unroll
        for (int j = 0; j < 2; ++j)
#pragma unroll
            for (int e = 0; e < 16; ++e) acc[i][j][e] = 0.f;
#pragma unroll
    for (int ks = 0; ks < 8; ++ks) {
        const int lb = 16 * ks + 8 * h;
        const f32x4 d0 = *(LAS const f32x4*)(dtl + lb), d1 = *(LAS const f32x4*)(dtl + lb + 4), a0 = *(LAS const f32x4*)(acs + lb), a1 = *(LAS const f32x4*)(acs + lb + 4);
        float wg[8];
#pragma unroll
        for (int e = 0; e < 4; ++e) { wg[e] = d0[e] * __expf(alast - a0[e]); wg[4 + e] = d1[e] * __expf(alast - a1[e]); }
        bf16x8 A[2], B[2];
#pragma unroll
        for (int pt = 0; pt < 2; ++pt) A[pt] = cat4(lds_tr4(xt, lb, xc + pt, lane), lds_tr4(xt, lb + 4, xc + pt, lane));
#pragma unroll
        for (int nt = 0; nt < 2; ++nt) { const s16x4 t0 = lds_tr4(bt, lb, 2 * nh + nt, lane), t1 = lds_tr4(bt, lb + 4, 2 * nh + nt, lane);
            u32x4 pk; pk.x = cvt_pk_bf16(bfs2f(t0[0]) * wg[0], bfs2f(t0[1]) * wg[1]); pk.y = cvt_pk_bf16(bfs2f(t0[2]) * wg[2], bfs2f(t0[3]) * wg[3]);
            pk.z = cvt_pk_bf16(bfs2f(t1[0]) * wg[4], bfs2f(t1[1]) * wg[5]); pk.w = cvt_pk_bf16(bfs2f(t1[2]) * wg[6], bfs2f(t1[3]) * wg[7]);
            B[nt] = __builtin_bit_cast(bf16x8, pk); }
#pragma unroll
        for (int pt = 0; pt < 2; ++pt)
#pragma unroll
            for (int nt = 0; nt < 2; ++nt) acc[pt][nt] = MFMA32(A[pt], B[nt], acc[pt][nt]);
    }
    unsigned* So = (unsigned*)STATES + ((size_t)(c * 32 + hd) * 64) * 64;
    const bool odd = lane & 1;
#pragma unroll
    for (int pt = 0; pt < 2; ++pt)
#pragma unroll
        for (int nt = 0; nt < 2; ++nt)
#pragma unroll
            for (int i = 0; i < 16; i += 2) { const int p0 = 32 * pt + (i & 3) + 8 * (i >> 2) + 4 * h, n = 64 * nh + 32 * nt + (lane & 31);
                const float mine0 = acc[pt][nt][i], mine1 = acc[pt][nt][i + 1];
                const float got = __int_as_float(__builtin_amdgcn_update_dpp(0, __float_as_int(odd ? mine0 : mine1), 0xB1, 0xf, 0xf, true));
                const unsigned w = odd ? cvt_pk_bf16(got, mine1) : cvt_pk_bf16(mine0, got);
                So[(p0 + (odd ? 1 : 0)) * 64 + (n >> 1)] = w; }
    if (nh == 0 && lane == 0) CDEC[c * 32 + hd] = __expf(alast);
}

__device__ __forceinline__ void ssd_scan(const float* __restrict__ STATES, const float* __restrict__ CDEC, bf16_t* __restrict__ PREV, size_t gt, size_t NGT) {
    typedef float f32x2 __attribute__((ext_vector_type(2)));
    for (size_t e = gt; e < (size_t)NSH * 64 * 128 / 2; e += NGT) {
        const int hd = (int)(e >> 12);
        f32x2 s = {0.f, 0.f};
        for (int cb = 0; cb < 128; cb += 16) {
            f32x2 v[16]; float d[16];
#pragma unroll
            for (int k = 0; k < 16; ++k) { const unsigned w = ((const unsigned*)STATES + (size_t)(cb + k) * NSH * 64 * 64)[e]; v[k][0] = __uint_as_float(w << 16); v[k][1] = __uint_as_float(w & 0xffff0000u); d[k] = CDEC[(cb + k) * 32 + hd]; }
#pragma unroll
            for (int k = 0; k < 16; ++k) { ((unsigned*)(PREV + (size_t)(cb + k) * NSH * 64 * 128))[e] = cvt_pk_bf16(s[0], s[1]); s = s * d[k] + v[k]; }
        }
    }
}

__device__ __forceinline__ void ssd_pass3_unit(LAS unsigned char* lds, const bf16_t* PREV, const float* dskip, const bf16_t* Z, bf16_t* MIX, float* rss, int c, int g, int tid, int lane, int wave) {
    const int r = wave >> 1, lh = wave & 1, h = lane >> 5, l31 = lane & 31, hd = 4 * g + r;
    LAS const unsigned char* xt = lds + SSD_XT + (r >> 1) * 32768; const unsigned xc = 2 * (r & 1);
    LAS const unsigned char* bt = lds + SSD_BT; LAS const unsigned char* ct = lds + SSD_CT;
    LAS const float* dtl = (LAS const float*)(lds + SSD_DT) + r * 128; LAS const float* acs = (LAS const float*)(lds + SSD_ACS) + r * 128;
    const float Dh = dskip[hd];
    f32x16 acc[2][2];
#pragma unroll
    for (int i = 0; i < 2; ++i)
#pragma unroll
        for (int j = 0; j < 2; ++j)
#pragma unroll
            for (int e = 0; e < 16; ++e) acc[i][j][e] = 0.f;
    {
        bf16x8 P[2][8]; const bf16_t* pv = PREV + ((size_t)(c * 32 + hd) * 64) * 128;
#pragma unroll
        for (int pt = 0; pt < 2; ++pt)
#pragma unroll
            for (int ks = 0; ks < 8; ++ks) P[pt][ks] = *(const bf16x8*)(pv + (32 * pt + l31) * 128 + 16 * ks + 8 * h);
#pragma unroll
        for (int lt = 0; lt < 2; ++lt) { const int l0 = 32 * (lt ? 3 - lh : lh);
#pragma unroll
            for (int ks = 0; ks < 8; ++ks) { const bf16x8 Cf = lds_row8(ct, l0 + l31, 2 * ks + h);
#pragma unroll
                for (int pt = 0; pt < 2; ++pt) acc[lt][pt] = MFMA32(Cf, P[pt][ks], acc[lt][pt]); }
#pragma unroll
            for (int q4 = 0; q4 < 4; ++q4) { const f32x4 a = *(LAS const f32x4*)(acs + l0 + 8 * q4 + 4 * h);
#pragma unroll
                for (int e = 0; e < 4; ++e) { const float f = __expf(a[e]); acc[lt][0][4 * q4 + e] *= f; acc[lt][1][4 * q4 + e] *= f; } } }
    }
#pragma unroll
    for (int lt = 0; lt < 2; ++lt) {
        const int gl = lt ? 3 - lh : lh, l0 = 32 * gl, lrow = l0 + l31; const float acs_l = acs[lrow];
        for (int st = 0; st <= gl; ++st) { const int s0 = 32 * st;
            f32x16 X;
#pragma unroll
            for (int e = 0; e < 16; ++e) X[e] = 0.f;
#pragma unroll
            for (int ks = 0; ks < 8; ++ks) { const bf16x8 Bf = lds_row8(bt, s0 + l31, 2 * ks + h), Cf = lds_row8(ct, l0 + l31, 2 * ks + h); X = MFMA32(Bf, Cf, X); }
            float w[16];
#pragma unroll
            for (int q4 = 0; q4 < 4; ++q4) { const int sb = s0 + 8 * q4 + 4 * h; const f32x4 as = *(LAS const f32x4*)(acs + sb), ds = *(LAS const f32x4*)(dtl + sb);
#pragma unroll
                for (int e = 0; e < 4; ++e) { const int s = sb + e; float v = X[4 * q4 + e] * __expf(fminf(acs_l - as[e], 0.f)) * ds[e]; v = (s <= lrow) ? v : 0.f; v = (s == lrow) ? v + Dh : v; w[4 * q4 + e] = v; } }
#pragma unroll
            for (int kp = 0; kp < 2; ++kp) { u32x4 pk; pk.x = cvt_pk_bf16(w[8 * kp + 0], w[8 * kp + 1]); pk.y = cvt_pk_bf16(w[8 * kp + 2], w[8 * kp + 3]); pk.z = cvt_pk_bf16(w[8 * kp + 4], w[8 * kp + 5]); pk.w = cvt_pk_bf16(w[8 * kp + 6], w[8 * kp + 7]);
                const bf16x8 Wf = __builtin_bit_cast(bf16x8, pk); const int rowb = s0 + 16 * kp + 4 * h;
#pragma unroll
                for (int pt = 0; pt < 2; ++pt) { const bf16x8 Xf = cat4(lds_tr4(xt, rowb, xc + pt, lane), lds_tr4(xt, rowb + 8, xc + pt, lane)); acc[lt][pt] = MFMA32(Wf, Xf, acc[lt][pt]); } }
        }
    }
    __syncthreads();
    const int row = tid >> 2, qd = tid & 3; const size_t trow = (size_t)(c * 128 + row);
    {
        const bf16_t* zp = Z + trow * DSSM + g * 256 + qd * 64;
#pragma unroll
        for (int j = 0; j < 8; ++j) *(LAS u32x4*)(lds + row * 512 + qd * 128 + j * 16) = *(const u32x4*)(zp + j * 8);
    }
    __syncthreads();
#pragma unroll
    for (int lt = 0; lt < 2; ++lt)
#pragma unroll
        for (int pt = 0; pt < 2; ++pt)
#pragma unroll
            for (int i = 0; i < 16; ++i) { const int l = 32 * (lt ? 3 - lh : lh) + (i & 3) + 8 * (i >> 2) + 4 * h, col = 64 * r + 32 * pt + l31;
                LAS unsigned short* zp = (LAS unsigned short*)(lds + l * 512 + col * 2); const float zv = bf2f(*zp);
                *zp = (unsigned short)(cvt_pk_bf16(acc[lt][pt][i] * silu_f(zv), 0.f) & 0xffffu); }
    __syncthreads();
    {
        bf16_t* op = MIX + trow * DM + g * 256 + qd * 64; float ss = 0.f;
#pragma unroll
        for (int j = 0; j < 8; ++j) { const u32x4 v = *(LAS const u32x4*)(lds + row * 512 + qd * 128 + j * 16); float f[8]; unpack8(v, f);
#pragma unroll
            for (int e = 0; e < 8; ++e) ss += f[e] * f[e];
            *(u32x4*)(op + j * 8) = v; }
        ss += __shfl_xor(ss, 1); ss += __shfl_xor(ss, 2);
        if (qd == 0) unsafeAtomicAdd(rss + trow, ss);
    }
    __syncthreads();
}
constexpr int ATT_K = 0, ATT_V = 32768;
__device__ __forceinline__ unsigned off64(unsigned row, unsigned ch) { return 128u * row + 16u * (ch ^ (row & 7)); }
__device__ __forceinline__ s16x4 lds_tr4_64(LAS const unsigned char* tile, unsigned rowbase, unsigned c32, unsigned lane) {
    const unsigned blk = (lane >> 4) & 1, q = (lane & 15) >> 2, p = lane & 3;
    LAS const unsigned char* a = tile + off64(rowbase + q, 4 * c32 + 2 * blk + (p >> 1)) + 8 * (p & 1);
    return __builtin_bit_cast(s16x4, __builtin_amdgcn_ds_read_tr16_b64_v4i16((LAS s16x4*)a));
}
__device__ __forceinline__ void attn_unit(LAS unsigned char* lds, const bf16_t* Q, const bf16_t* Kb, const bf16_t* V, const float* sinks, bf16_t* MIX, int nb, int kv, int tid, int lane, int wave) {
    const int hq = kv * 8 + wave, h = lane >> 5, l31 = lane & 31;
    bf16x8 Qf[4];
#pragma unroll
    for (int ks = 0; ks < 4; ++ks) Qf[ks] = *(const bf16x8*)(Q + (size_t)(128 * nb + l31) * 2048 + hq * 64 + 16 * ks + 8 * h);
#pragma unroll
    for (int j = 0; j < 4; ++j) { const int idx = tid + 512 * j, row = idx >> 3, ch = idx & 7; int tok = 128 * (nb - 1) + row; tok = tok < 0 ? 0 : tok;
        const size_t go = (size_t)tok * 256 + kv * 64 + ch * 8;
        *(LAS u32x4*)(lds + ATT_K + off64(row, ch)) = *(const u32x4*)(Kb + go);
        *(LAS u32x4*)(lds + ATT_V + off64(row, ch)) = *(const u32x4*)(V + go); }
    __syncthreads();
    const float sink = sinks[hq];
    LAS const unsigned char* kt_ = lds + ATT_K; LAS const unsigned char* vt_ = lds + ATT_V;
    for (int sb = 0; sb < 4; ++sb) {
        const size_t qrow = (size_t)(128 * nb + 32 * sb + l31);
        f32x16 S[5];
#pragma unroll
        for (int rel = 0; rel < 5; ++rel) {
#pragma unroll
            for (int e = 0; e < 16; ++e) S[rel][e] = 0.f;
#pragma unroll
            for (int ks = 0; ks < 4; ++ks) { const bf16x8 Kf = *(LAS const bf16x8*)(kt_ + off64(32 * (sb + rel) + l31, 2 * ks + h)); S[rel] = MFMA32(Kf, Qf[ks], S[rel]); }
        }
        if (sb < 3) {
#pragma unroll
            for (int ks = 0; ks < 4; ++ks) Qf[ks] = *(const bf16x8*)(Q + (qrow + 32) * 2048 + hq * 64 + 16 * ks + 8 * h); }
        float m = -1e30f;
#pragma unroll
        for (int rel = 0; rel < 5; ++rel) { const bool tile_ok = (nb > 0) || (sb + rel >= 4);
#pragma unroll
            for (int i = 0; i < 16; ++i) { const int kr = (i & 3) + 8 * (i >> 2) + 4 * h; bool ok = tile_ok;
                if (rel == 0) ok = ok && (kr > l31);
                if (rel == 4) ok = ok && (kr <= l31);
                const float s = ok ? S[rel][i] * 0.125f : -1e30f; S[rel][i] = s; m = fmaxf(m, s); } }
        m = fmaxf(m, __shfl_xor(m, 32)); m = fmaxf(m, sink);
        float lsum = 0.f;
#pragma unroll
        for (int rel = 0; rel < 5; ++rel)
#pragma unroll
            for (int i = 0; i < 16; ++i) { const float p = __expf(S[rel][i] - m); S[rel][i] = p; lsum += p; }
        lsum += __shfl_xor(lsum, 32); lsum += __expf(sink - m);
        f32x16 O[2];
#pragma unroll
        for (int dt = 0; dt < 2; ++dt)
#pragma unroll
            for (int e = 0; e < 16; ++e) O[dt][e] = 0.f;
#pragma unroll
        for (int rel = 0; rel < 5; ++rel)
#pragma unroll
            for (int kp = 0; kp < 2; ++kp) { u32x4 pk; pk.x = cvt_pk_bf16(S[rel][8 * kp + 0], S[rel][8 * kp + 1]); pk.y = cvt_pk_bf16(S[rel][8 * kp + 2], S[rel][8 * kp + 3]);
                pk.z = cvt_pk_bf16(S[rel][8 * kp + 4], S[rel][8 * kp + 5]); pk.w = cvt_pk_bf16(S[rel][8 * kp + 6], S[rel][8 * kp + 7]);
                const bf16x8 Pf = __builtin_bit_cast(bf16x8, pk); const int rowb = 32 * (sb + rel) + 16 * kp + 4 * h;
#pragma unroll
                for (int dt = 0; dt < 2; ++dt) { const bf16x8 Vf = cat4(lds_tr4_64(vt_, rowb, dt, lane), lds_tr4_64(vt_, rowb + 8, dt, lane)); O[dt] = MFMA32(Vf, Pf, O[dt]); } }
        const float inv = 1.f / lsum;
        bf16_t* op = MIX + qrow * DM + 2048 + hq * 64;
#pragma unroll
        for (int dt = 0; dt < 2; ++dt)
#pragma unroll
            for (int i4 = 0; i4 < 4; ++i4) { f32x4 v; v[0] = O[dt][4 * i4] * inv; v[1] = O[dt][4 * i4 + 1] * inv; v[2] = O[dt][4 * i4 + 2] * inv; v[3] = O[dt][4 * i4 + 3] * inv;
                *(u32x2*)(op + 32 * dt + 8 * i4 + 4 * h) = pack4(v); }
    }
    __syncthreads();
}
typedef int i32x4 __attribute__((ext_vector_type(4)));
__device__ __forceinline__ f32x4 acc_i2f(const f32x4 a) { return __builtin_convertvector(__builtin_bit_cast(i32x4, a), f32x4); }
__device__ __forceinline__ u32x2 pack8_i8(const f32x4 a, const f32x4 b) {
    u32x2 w; w.x = (unsigned)((int)a[0] & 255) | ((unsigned)((int)a[1] & 255) << 8) | ((unsigned)((int)a[2] & 255) << 16) | ((unsigned)(int)a[3] << 24);
    w.y = (unsigned)((int)b[0] & 255) | ((unsigned)((int)b[1] & 255) << 8) | ((unsigned)((int)b[2] & 255) << 16) | ((unsigned)(int)b[3] << 24); return w; }
__device__ __forceinline__ f32x4 sigm4(const f32x4 x) { const f32x4 t = x * -1.4426950408889634f; f32x4 ex;
#pragma unroll
    for (int i = 0; i < 4; ++i) ex[i] = __builtin_amdgcn_exp2f(t[i]);
    const f32x4 d = ex + 1.f; f32x4 r;
#pragma unroll
    for (int i = 0; i < 4; ++i) r[i] = __builtin_amdgcn_rcpf(d[i]);
    return r; }
__device__ __forceinline__ void unpack8v(const u32x4 w, f32x4& lo, f32x4& hi) {
    lo[0] = __uint_as_float(w.x << 16); lo[1] = __uint_as_float(w.x & 0xffff0000u); lo[2] = __uint_as_float(w.y << 16); lo[3] = __uint_as_float(w.y & 0xffff0000u);
    hi[0] = __uint_as_float(w.z << 16); hi[1] = __uint_as_float(w.z & 0xffff0000u); hi[2] = __uint_as_float(w.w << 16); hi[3] = __uint_as_float(w.w & 0xffff0000u); }
struct EpiInProj {
    static constexpr bool I8 = false, APERM = false, PERM = false, AFTER_DRAIN = false, HAS_MID = false; int tmid;
    bf16_t *Q, *Kb, *V, *Z, *XBC; float* DT; const float *rs0, *cosT, *sinT, *dt_bias;
    __device__ __forceinline__ void mid(f32x4 (&)[2][2][4][2], const pg8::Unit&, int, int) const {}
    __device__ __forceinline__ void operator()(const f32x4 (&acc)[2][2][4][2], const pg8::Unit& u, int wr, int wc, int fr, int fq) const {
        const int row0 = u.pm * 256 + wr * 64 + fr, pn = u.pn;
        if (pn < 9) {
            bf16_t* base = pn < 8 ? Q : Kb; const int ld = pn < 8 ? 2048 : 256, hb = pn < 8 ? pn * 4 : 0, dlo = 16 * (wc & 1) + 4 * fq;
#pragma unroll
            for (int ai = 0; ai < 2; ++ai) {
                float sv[4]; f32x4 cv[4], sn[4];
#pragma unroll
                for (int m = 0; m < 4; ++m) { const int row = row0 + ai * 128 + m * 16; sv[m] = rs0[row];
                    cv[m] = *(const f32x4*)(cosT + (size_t)row * 32 + dlo); sn[m] = *(const f32x4*)(sinT + (size_t)row * 32 + dlo); }
                asm volatile("" ::: "memory");
#pragma unroll
                for (int m = 0; m < 4; ++m) { const int row = row0 + ai * 128 + m * 16; const float s = sv[m]; const f32x4 c4 = cv[m], s4 = sn[m];
#pragma unroll
                    for (int bj = 0; bj < 2; ++bj) { const int hh = hb + 2 * bj + (wc >> 1); const f32x4 x1 = acc[ai][bj][m][0], x2 = acc[ai][bj][m][1];
                        const f32x4 o1 = (x1 * c4 - x2 * s4) * s, o2 = (x2 * c4 + x1 * s4) * s;
                        bf16_t* dst = base + (size_t)row * ld + hh * 64 + dlo;
                        *(u32x2*)dst = pack4(o1); *(u32x2*)(dst + 32) = pack4(o2); } }
                asm volatile("" ::: "memory"); }
        } else if (pn < 34) {
            bf16_t* base; int ld, col0;
            if (pn == 9) { base = V; ld = 256; col0 = 0; } else if (pn < 18) { base = Z; ld = 2048; col0 = (pn - 10) * 256; } else { base = XBC; ld = 4096; col0 = (pn - 18) * 256; }
            col0 += wc * 32 + 8 * fq;
            float sv[2][4];
#pragma unroll
            for (int ai = 0; ai < 2; ++ai)
#pragma unroll
                for (int m = 0; m < 4; ++m) sv[ai][m] = rs0[row0 + ai * 128 + m * 16];
            asm volatile("" ::: "memory");
#pragma unroll
            for (int ai = 0; ai < 2; ++ai)
#pragma unroll
                for (int m = 0; m < 4; ++m) { const int row = row0 + ai * 128 + m * 16; const float s = sv[ai][m];
#pragma unroll
                    for (int bj = 0; bj < 2; ++bj) *(u32x4*)(base + (size_t)row * ld + col0 + bj * 128) = pack8(acc[ai][bj][m][0] * s, acc[ai][bj][m][1] * s); }
        } else if (wc == 0) {
            const f32x4 b0 = *(const f32x4*)(dt_bias + 8 * fq), b1 = *(const f32x4*)(dt_bias + 8 * fq + 4);
            float sv[2][4];
#pragma unroll
            for (int ai = 0; ai < 2; ++ai)
#pragma unroll
                for (int m = 0; m < 4; ++m) sv[ai][m] = rs0[row0 + ai * 128 + m * 16];
            asm volatile("" ::: "memory");
#pragma unroll
            for (int ai = 0; ai < 2; ++ai)
#pragma unroll
                for (int m = 0; m < 4; ++m) { const int row = row0 + ai * 128 + m * 16; const float s = sv[ai][m];
                    f32x4 v0 = acc[ai][0][m][0] * s + b0, v1 = acc[ai][0][m][1] * s + b1;
#pragma unroll
                    for (int e = 0; e < 4; ++e) { v0[e] = softplus_f(v0[e]); v1[e] = softplus_f(v1[e]); }
                    *(f32x4*)(DT + (size_t)row * 32 + 8 * fq) = v0; *(f32x4*)(DT + (size_t)row * 32 + 8 * fq + 4) = v1; }
        }
    }
};
struct EpiWo {
    static constexpr bool I8 = false, APERM = false, PERM = false, AFTER_DRAIN = false, HAS_MID = true; int tmid;
    const float* x; bf16_t* HB; const float* rss_ssm; float* rss1; signed char* HQ; const float* rs0;
    __device__ __forceinline__ void mid(f32x4 (&acc)[2][2][4][2], const pg8::Unit& u, int wr, int fr) const {
#pragma unroll
        for (int ai = 0; ai < 2; ++ai)
#pragma unroll
            for (int m = 0; m < 4; ++m) { const int row = u.pm * 256 + wr * 64 + fr + ai * 128 + m * 16; const float sc = rsqrtf(rss_ssm[row] * (1.f / DSSM) + EPS);
#pragma unroll
                for (int bj = 0; bj < 2; ++bj)
#pragma unroll
                    for (int n = 0; n < 2; ++n) acc[ai][bj][m][n] *= sc; }
    }
    __device__ __forceinline__ void operator()(const f32x4 (&acc)[2][2][4][2], const pg8::Unit& u, int wr, int wc, int fr, int fq) const {
        const int row0 = u.pm * 256 + wr * 64 + fr, col0 = u.pn * 256 + wc * 32 + 8 * fq;
#pragma unroll
        for (int ai = 0; ai < 2; ++ai)
#pragma unroll
            for (int mp = 0; mp < 2; ++mp) {
                f32x4 xr[2][2][2]; float iqv[2];
#pragma unroll
                for (int mm = 0; mm < 2; ++mm) { const int row = row0 + ai * 128 + (2 * mp + mm) * 16; iqv[mm] = rs0[row];
#pragma unroll
                    for (int bj = 0; bj < 2; ++bj) { const size_t off = (size_t)row * DM + col0 + bj * 128; xr[mm][bj][0] = *(const f32x4*)(x + off); xr[mm][bj][1] = *(const f32x4*)(x + off + 4); } }
#pragma unroll
                for (int mm = 0; mm < 2; ++mm) { const int m = 2 * mp + mm, row = row0 + ai * 128 + m * 16; float ss = 0.f; const float iq = (127.f / QCLIP) * iqv[mm];
#pragma unroll
                    for (int bj = 0; bj < 2; ++bj) { const size_t off = (size_t)row * DM + col0 + bj * 128;
                        const f32x4 h0 = xr[mm][bj][0] + acc[ai][bj][m][0], h1 = xr[mm][bj][1] + acc[ai][bj][m][1];
                        *(u32x4*)(HB + off) = pack8(h0, h1);
                        { f32x4 q0, q1;
#pragma unroll
                          for (int ee = 0; ee < 4; ++ee) { q0[ee] = fminf(fmaxf(rintf(h0[ee] * iq), -127.f), 127.f); q1[ee] = fminf(fmaxf(rintf(h1[ee] * iq), -127.f), 127.f); }
                          *(u32x2*)(HQ + off) = pack8_i8(q0, q1); }
                        ss += (h0[0] * h0[0] + h0[1] * h0[1]) + (h0[2] * h0[2] + h0[3] * h0[3]) + (h1[0] * h1[0] + h1[1] * h1[1]) + (h1[2] * h1[2] + h1[3] * h1[3]); }
                    ss += __shfl_xor(ss, 16); ss += __shfl_xor(ss, 32);
                    if (fq == 0) unsafeAtomicAdd(rss1 + row, ss); }
                asm volatile("" ::: "memory"); }
    }
};
struct EpiUpPlain {
    static constexpr bool I8 = false, APERM = false, PERM = false, AFTER_DRAIN = false, HAS_MID = false; int tmid;
    bf16_t* U; const float* rss1;
    __device__ __forceinline__ void mid(f32x4 (&)[2][2][4][2], const pg8::Unit&, int, int) const {}
    __device__ __forceinline__ void operator()(const f32x4 (&acc)[2][2][4][2], const pg8::Unit& u, int wr, int wc, int fr, int fq) const {
        const int row0 = u.pm * 256 + wr * 64 + fr, col0 = u.pn * 256 + wc * 32 + 8 * fq;
#pragma unroll
        for (int ai = 0; ai < 2; ++ai)
#pragma unroll
            for (int m = 0; m < 4; ++m) { const int row = row0 + ai * 128 + m * 16; const float s = rsqrtf(rss1[row] * (1.f / DM) + EPS);
#pragma unroll
                for (int bj = 0; bj < 2; ++bj) *(u32x4*)(U + (size_t)row * DFF + col0 + bj * 128) = pack8(acc[ai][bj][m][0] * s, acc[ai][bj][m][1] * s); }
    }
};
struct EpiDown {
    static constexpr bool I8 = false, APERM = false, PERM = false, AFTER_DRAIN = false, HAS_MID = false; int tmid;
    bf16_t* HB; signed char* HQ; const float* rss1;
    __device__ __forceinline__ void mid(f32x4 (&)[2][2][4][2], const pg8::Unit&, int, int) const {}
    __device__ __forceinline__ void operator()(const f32x4 (&acc)[2][2][4][2], const pg8::Unit& u, int wr, int wc, int fr, int fq) const {
        const int row0 = u.pm * 256 + wr * 64 + fr, col0 = u.pn * 256 + wc * 32 + 8 * fq;
#pragma unroll
        for (int ai = 0; ai < 2; ++ai) {
            u32x4 hr[4][2]; float q1v[4];
#pragma unroll
            for (int m = 0; m < 4; ++m) { q1v[m] = rss1[row0 + ai * 128 + m * 16];
#pragma unroll
                for (int bj = 0; bj < 2; ++bj) hr[m][bj] = *(const u32x4*)(HB + (size_t)(row0 + ai * 128 + m * 16) * DM + col0 + bj * 128); }
#pragma unroll
            for (int m = 0; m < 4; ++m) { const float iq = (127.f / QCLIP) * rsqrtf(q1v[m] * (1.f / DM) + EPS);
#pragma unroll
                for (int bj = 0; bj < 2; ++bj) { float hv[8]; unpack8(hr[m][bj], hv); const size_t off = (size_t)(row0 + ai * 128 + m * 16) * DM + col0 + bj * 128;
                    f32x4 h0 = acc[ai][bj][m][0], h1 = acc[ai][bj][m][1];
#pragma unroll
                    for (int e = 0; e < 4; ++e) { h0[e] += hv[e]; h1[e] += hv[4 + e]; }
                    *(u32x4*)(HB + off) = pack8(h0, h1);
                    f32x4 q0, q1;
#pragma unroll
                    for (int ee = 0; ee < 4; ++ee) { q0[ee] = fminf(fmaxf(rintf(h0[ee] * iq), -127.f), 127.f); q1[ee] = fminf(fmaxf(rintf(h1[ee] * iq), -127.f), 127.f); }
                    *(u32x2*)(HQ + off) = pack8_i8(q0, q1); } }
            asm volatile("" ::: "memory"); }
    }
};
struct EpiBf {
    static constexpr bool I8 = false, APERM = false, PERM = false, AFTER_DRAIN = false, HAS_MID = false; int tmid;
    bf16_t* O; int ldo;
    __device__ __forceinline__ void mid(f32x4 (&)[2][2][4][2], const pg8::Unit&, int, int) const {}
    __device__ __forceinline__ void operator()(const f32x4 (&acc)[2][2][4][2], const pg8::Unit& u, int wr, int wc, int fr, int fq) const {
        const int row0 = u.pm * 256 + wr * 64 + fr, col0 = u.pn * 256 + wc * 32 + 8 * fq;
#pragma unroll
        for (int ai = 0; ai < 2; ++ai)
#pragma unroll
            for (int m = 0; m < 4; ++m) { const int row = row0 + ai * 128 + m * 16;
#pragma unroll
                for (int bj = 0; bj < 2; ++bj) *(u32x4*)(O + (size_t)row * ldo + col0 + bj * 128) = pack8(acc[ai][bj][m][0], acc[ai][bj][m][1]); }
    }
};
struct EpiGate {
    static constexpr bool I8 = true, APERM = false, PERM = false, AFTER_DRAIN = false, HAS_MID = false; int tmid;
    float* H; const bf16_t* HB; const bf16_t* PP; const float* bg; float* rss3; const float* rss1; const float* cmax;
    __device__ __forceinline__ void mid(f32x4 (&)[2][2][4][2], const pg8::Unit&, int, int) const {}
    __device__ __forceinline__ void operator()(const f32x4 (&acc)[2][2][4][2], const pg8::Unit& u, int wr, int wc, int fr, int fq) const {
        const int row0 = u.pm * 256 + wr * 64 + fr, col0 = u.pn * 256 + wc * 32 + 8 * fq;
        f32x4 bv[2][2], sb[2][2];
#pragma unroll
        for (int bj = 0; bj < 2; ++bj) { bv[bj][0] = *(const f32x4*)(bg + col0 + bj * 128); bv[bj][1] = *(const f32x4*)(bg + col0 + bj * 128 + 4);
            sb[bj][0] = *(const f32x4*)(cmax + col0 + bj * 128) * (1.f / 127.f); sb[bj][1] = *(const f32x4*)(cmax + col0 + bj * 128 + 4) * (1.f / 127.f); }
#pragma unroll
        for (int ai = 0; ai < 2; ++ai)
#pragma unroll
            for (int mp = 0; mp < 2; ++mp) {
                u32x4 hr[2][2], pr[2][2]; float q1v[2];
#pragma unroll
                for (int mm = 0; mm < 2; ++mm) { const int row = row0 + ai * 128 + (2 * mp + mm) * 16; q1v[mm] = rss1[row];
#pragma unroll
                    for (int bj = 0; bj < 2; ++bj) { const size_t off = (size_t)row * DM + col0 + bj * 128; hr[mm][bj] = *(const u32x4*)(HB + off); pr[mm][bj] = *(const u32x4*)(PP + off); } }
#pragma unroll
                for (int mm = 0; mm < 2; ++mm) { const int m = 2 * mp + mm, row = row0 + ai * 128 + m * 16; f32x4 ssv = {0.f, 0.f, 0.f, 0.f}; const float sa = (QCLIP / 127.f) * sqrtf(q1v[mm] * (1.f / DM) + EPS);
#pragma unroll
                    for (int bj = 0; bj < 2; ++bj) { const size_t off = (size_t)row * DM + col0 + bj * 128;
                        f32x4 p0, p1, x0, x1; unpack8v(pr[mm][bj], p0, p1); unpack8v(hr[mm][bj], x0, x1);
                        const f32x4 g0 = acc_i2f(acc[ai][bj][m][0]) * (sb[bj][0] * sa) + bv[bj][0], g1 = acc_i2f(acc[ai][bj][m][1]) * (sb[bj][1] * sa) + bv[bj][1];
                        const f32x4 h0 = x0 + p0 * sigm4(g0), h1 = x1 + p1 * sigm4(g1);
                        *(f32x4*)(H + off) = h0; *(f32x4*)(H + off + 4) = h1;
                        ssv = ssv + h0 * h0; ssv = ssv + h1 * h1; }
                    float ss = (ssv[0] + ssv[1]) + (ssv[2] + ssv[3]);
                    ss += __shfl_xor(ss, 16); ss += __shfl_xor(ss, 32);
                    if (fq == 0) unsafeAtomicAdd(rss3 + row, ss); }
                asm volatile("" ::: "memory"); }
    }
};


__device__ __forceinline__ float dpp_shr1z(float src) { return __int_as_float(__builtin_amdgcn_update_dpp(0, __float_as_int(src), 0x111, 0xf, 0xf, true)); }
__device__ __forceinline__ f32x4 shr1z4(const f32x4 a) { f32x4 r; r[0] = dpp_shr1z(a[0]); r[1] = dpp_shr1z(a[1]); r[2] = dpp_shr1z(a[2]); r[3] = dpp_shr1z(a[3]); return r; }
struct EpiUpConv {
    static constexpr bool I8 = true, APERM = true, PERM = false, AFTER_DRAIN = false, HAS_MID = false; int tmid;
    bf16_t* ACT; const float* rss1; const float* cw; const float* cb; LAS float* X; const float* rs0; const float* cmax;
    __device__ __forceinline__ void mid(f32x4 (&)[2][2][4][2], const pg8::Unit&, int, int) const {}
    __device__ __forceinline__ void conv4(f32x4 (&y)[4], const f32x4 (&x)[4], LAS const float* wl) const {
        const f32x4 w0 = *(LAS const f32x4*)wl, w1 = *(LAS const f32x4*)(wl + 128), w2 = *(LAS const f32x4*)(wl + 256), b = *(LAS const f32x4*)(wl + 384);
        const f32x4 x1 = shr1z4(x[3]), x2 = shr1z4(x[2]);
        y[0] = b + w2 * x[0] + w1 * x1 + w0 * x2;
        y[1] = b + w2 * x[1] + w1 * x[0] + w0 * x1;
        y[2] = b + w2 * x[2] + w1 * x[1] + w0 * x[0];
        y[3] = b + w2 * x[3] + w1 * x[2] + w0 * x[1];
    }
    __device__ __forceinline__ void operator()(const f32x4 (&acc)[2][2][4][2], const pg8::Unit& u, int wr, int wc, int fr, int fq) const {
        const int T0 = 254 * u.pm - 2, colp = wc * 32 + 8 * fq, cbase = u.pn * 128 + colp;
        LAS float* WL = X + 2048;
        typedef float f32x2 __attribute__((ext_vector_type(2)));
        const int tid = (wr * 4 + wc) * 64 + fq * 16 + fr, q = tid >> 6, c2 = (tid & 63) * 2, gu = q >> 2, k = q & 3;
        const float* src = (k < 3 ? cw + (size_t)k * 2 * DFF : cb) + gu * DFF + u.pn * 128 + c2;
        f32x2 wv = *(const f32x2*)src;
        const f32x2 cm = *(const f32x2*)(cmax + gu * DFF + u.pn * 128 + c2);
        float qv[2][4], r0v[2][4];
#pragma unroll
        for (int ai = 0; ai < 2; ++ai)
#pragma unroll
            for (int m = 0; m < 4; ++m) { const int t = T0 + ai * 128 + wr * 64 + 4 * fr + m; const int tc = ((t >= 0) && (t < SEQ)) ? t : 0; qv[ai][m] = rss1[tc]; r0v[ai][m] = rs0[tc]; }
        asm volatile("" ::: "memory");
        if (k < 3) wv = wv * cm * (1.f / 127.f);
        *(LAS f32x2*)(WL + q * 128 + c2) = wv;
        float rs[2][4];
#pragma unroll
        for (int ai = 0; ai < 2; ++ai)
#pragma unroll
            for (int m = 0; m < 4; ++m) { const int t = T0 + ai * 128 + wr * 64 + 4 * fr + m; const bool ok = (t >= 0) && (t < SEQ);
                rs[ai][m] = ok ? rsqrtf(qv[ai][m] * (1.f / DM) + EPS) * (QCLIP / 127.f) * __builtin_amdgcn_rcpf(r0v[ai][m]) : 0.f; }
        if (fr == 15) {
#pragma unroll
            for (int ai = 0; ai < 2; ++ai)
#pragma unroll
                for (int bj = 0; bj < 2; ++bj)
#pragma unroll
                    for (int n = 0; n < 2; ++n) { *(LAS f32x4*)(X + ((2 * ai + wr) * 2 + 0) * 256 + bj * 128 + colp + 4 * n) = acc_i2f(acc[ai][bj][2][n]) * rs[ai][2];
                                                  *(LAS f32x4*)(X + ((2 * ai + wr) * 2 + 1) * 256 + bj * 128 + colp + 4 * n) = acc_i2f(acc[ai][bj][3][n]) * rs[ai][3]; }
        }
        asm volatile("s_waitcnt lgkmcnt(0)" ::: "memory"); __builtin_amdgcn_s_barrier(); asm volatile("" ::: "memory");
#pragma unroll
        for (int ai = 0; ai < 2; ++ai) {
            const int pb = 2 * ai + wr - 1;
#pragma unroll
            for (int n = 0; n < 2; ++n) {
                const int cl = colp + 4 * n, cch = cbase + 4 * n;
                asm volatile("" ::: "memory");
                f32x4 yg[4], yu[4];
                { f32x4 x[4];
#pragma unroll
                  for (int m = 0; m < 4; ++m) x[m] = acc_i2f(acc[ai][0][m][n]) * rs[ai][m];
                  conv4(yg, x, WL + cl); }
                asm volatile("" : "+v"(yg[0]), "+v"(yg[1]), "+v"(yg[2]), "+v"(yg[3]) :: "memory");
                { f32x4 x[4];
#pragma unroll
                  for (int m = 0; m < 4; ++m) x[m] = acc_i2f(acc[ai][1][m][n]) * rs[ai][m];
                  conv4(yu, x, WL + 512 + cl); }
                if (fr == 0 && pb >= 0) {
                    const f32x4 h1g = *(LAS const f32x4*)(X + (pb * 2 + 1) * 256 + cl), h2g = *(LAS const f32x4*)(X + (pb * 2) * 256 + cl);
                    const f32x4 h1u = *(LAS const f32x4*)(X + (pb * 2 + 1) * 256 + 128 + cl), h2u = *(LAS const f32x4*)(X + (pb * 2) * 256 + 128 + cl);
                    const f32x4 g0 = *(LAS const f32x4*)(WL + cl), g1 = *(LAS const f32x4*)(WL + 128 + cl), u0 = *(LAS const f32x4*)(WL + 512 + cl), u1 = *(LAS const f32x4*)(WL + 640 + cl);
                    yg[0] += g1 * h1g + g0 * h2g; yg[1] += g0 * h1g; yu[0] += u1 * h1u + u0 * h2u; yu[1] += u0 * h1u;
                }
#pragma unroll
                for (int m = 0; m < 4; ++m) { const int R = ai * 128 + wr * 64 + 4 * fr + m, t = T0 + R;
                    if (R >= 2 && t < SEQ) { const f32x4 o = yg[m] * sigm4(yg[m]) * yu[m]; *(u32x2*)(ACT + (size_t)t * DFF + cch) = pack4(o); } }
            }
        }
    }
};
constexpr int LDS_BYTES = 147456;
constexpr int RING_BYTES = 131072, MISC_OFF = RING_BYTES + 320;
constexpr int N_PHASES = 10;
struct Args { const float* in[22]; float* out; unsigned char* ws; int ph_lo, ph_hi, li, pad; };
struct PpOrder {
    int c, G;
    __device__ __forceinline__ bool next(int i, pg8::Unit& u) const {
        int L;
        if (G == 256) { if (c < 192) { if (i >= 2) return false; L = c * 2 + i; } else { if (i >= 10) return false; L = 384 + (c - 192) * 10 + i; } }
        else { L = i * G + c; if (L >= 1024) return false; }
        u.pm = L >> 4; u.pn = L & 15; return true;
    }
    __device__ __forceinline__ void a_ready(const pg8::Unit&) const {}
    __device__ __forceinline__ void done(const pg8::Unit&) const {}
};
typedef const __attribute__((address_space(4))) Args* ArgsP;
__device__ __forceinline__ ArgsP fresh_args() { ArgsP p = (ArgsP)__builtin_amdgcn_kernarg_segment_ptr(); asm volatile("" : "+s"(p)); return p; }
__device__ __forceinline__ int fresh_tid() { int t = threadIdx.x; asm volatile("" : "+v"(t)); return t; }
#define PH_IDS() ArgsP ap = fresh_args(); unsigned char* ws = ap->ws; float* ctl = (float*)(ws + WS_CTL); const int tid = fresh_tid(), lane = tid & 63, wave = __builtin_amdgcn_readfirstlane(tid >> 6); \
    const int G = gridDim.x, c = blockIdx.x, gw = c * 8 + wave, NGW = G * 8; const size_t gt = (size_t)c * 512 + tid, NGT = (size_t)G * 512; \
    (void)ctl; (void)lane; (void)gw; (void)NGW; (void)gt; (void)NGT; (void)ws
__global__ void __launch_bounds__(512, 2) k_fwd(Args a_unused) {
    extern __shared__ __attribute__((aligned(16))) unsigned char lds_raw[];
    LAS unsigned char* lds = (LAS unsigned char*)lds_raw;
    int lo, hi;
    XcdBarrier bar;
    {   PH_IDS();
        volatile LAS unsigned* MISC = (volatile LAS unsigned*)(lds + MISC_OFF);
        for (int u = tid; u < (LDS_BYTES - RING_BYTES) / 4; u += 512) ((LAS unsigned*)(lds + RING_BYTES))[u] = 0u;
        __syncthreads();
        bar = xcd_barrier_post((unsigned*)ctl + CW_BAR + ap->li * XCD_BAR_WORDS, MISC + 8);
        lo = ap->ph_lo; hi = ap->ph_hi; }
#define IN(k) (lo <= (k) && (k) < hi)
#define SEAM(k) do { if (IN(k) && IN((k) + 1)) xcd_barrier(bar); } while (0)

    if (IN(0)) { PH_IDS();
        LAS unsigned* scr = (LAS unsigned*)(lds + wave * 16384);
        TrJob j; j.pad = 0; j.qmax = nullptr;
        j.W = ap->in[4]; j.WT = (bf16_t*)(ws + WS_WIN); j.kscale = ap->in[3]; j.K = DM; j.N = NPROJ; j.nrows = NPROJ_PAD; j.kind = 1; j.kxor = 0; j.kscale_n = DM; ph_transpose(j, scr, gw, NGW, lane);
        j.kscale = nullptr; j.K = DM; j.N = DM; j.nrows = DM; j.kind = 0; j.kxor = 0; j.kscale_n = 0;
        j.W = ap->in[20]; j.WT = (bf16_t*)(ws + WS_WP); j.K = PLE; ph_transpose(j, scr, gw, NGW, lane);
        ph_xprep(ap->in[0], (bf16_t*)(ws + WS_XB), (float*)(ws + WS_RS0), gw, NGW, lane);
        ph_pprep(ap->in[1], (bf16_t*)(ws + WS_PB), gt, NGT);
        ph_trig((const int*)ap->in[2], (float*)(ws + WS_COS), (float*)(ws + WS_SIN), gt, NGT);
    }
    SEAM(0);
    if (IN(1)) { PH_IDS();
        { pg8::Gemm g{(const bf16_t*)(ws + WS_XB), (const bf16_t*)(ws + WS_WIN), SEQ, NPROJ_PAD, DM}; pg8::StaticOrder S; S.init(SEQ, NPROJ_PAD, G, c);
          EpiInProj E{0, (bf16_t*)(ws + WS_Q), (bf16_t*)(ws + WS_K), (bf16_t*)(ws + WS_V), (bf16_t*)(ws + WS_Z), (bf16_t*)(ws + WS_XBC), (float*)(ws + WS_DT),
                      (const float*)(ws + WS_RS0), (const float*)(ws + WS_COS), (const float*)(ws + WS_SIN), ap->in[8]};
          pg8::gemm_phase<EpiInProj, pg8::StaticOrder, true, true>(lds, g, S, E); }
        { pg8::Gemm g{(const bf16_t*)(ws + WS_PB), (const bf16_t*)(ws + WS_WP), SEQ, DM, PLE}; PpOrder S{c, G};
          EpiBf E{0, (bf16_t*)(ws + WS_PP), DM};
          pg8::gemm_phase<EpiBf, PpOrder, true, true>(lds, g, S, E); }
    }
    SEAM(1);
    if (IN(2)) { PH_IDS();
        for (int u = c; u < 512; u += G) attn_unit(lds, (const bf16_t*)(ws + WS_Q), (const bf16_t*)(ws + WS_K), (const bf16_t*)(ws + WS_V), ap->in[5], (bf16_t*)(ws + WS_MIX), u >> 2, u & 3, tid, lane, wave);
        for (int u = c; u < 1024; u += G) { const int ch = u >> 3, g = u & 7;
            ssd_stage<false>(lds, (const bf16_t*)(ws + WS_XBC), ap->in[6], ap->in[7], (const float*)(ws + WS_DT), ap->in[9], ch, g, tid, lane, wave);
            ssd_pass1_unit(lds, (float*)(ws + WS_STATES), (float*)(ws + WS_CDEC), ch, g, lane, wave);
            __syncthreads(); }
    }
    if (IN(2)) { PH_IDS();
        ph_colmax(ap->in[14], ap->in[13], DM, 2 * DFF, (unsigned*)ctl + CW_CMAX_UP, gw, NGW, lane);
        ph_colmax(ap->in[18], nullptr, DM, DM, (unsigned*)ctl + CW_CMAX_G, gw, NGW, lane);
    }
    SEAM(2);
    if (IN(3)) { PH_IDS(); ssd_scan((const float*)(ws + WS_STATES), (const float*)(ws + WS_CDEC), (bf16_t*)(ws + WS_PREV), gt, NGT);
        LAS unsigned* scr = (LAS unsigned*)(lds + wave * 16384);
        TrJob j; j.pad = 0; j.qmax = nullptr;
        j.W = ap->in[12]; j.WT = (bf16_t*)(ws + WS_WO); j.kscale = ap->in[11]; j.K = DM; j.N = DM; j.nrows = DM; j.kind = 0; j.kxor = 2048; j.kscale_n = 2048; ph_transpose(j, scr, gw, NGW, lane);
        j.qmax = ctl + CW_CMAX_UP; j.W = ap->in[14]; j.WT = (bf16_t*)(ws + WS_WUP); j.kscale = ap->in[13]; j.K = DM; j.N = 2 * DFF; j.nrows = 2 * DFF; j.kind = 2; j.kxor = 0; j.kscale_n = DM; ph_transpose_q8(j, scr, gw, NGW, lane); j.qmax = nullptr;
        j.W = ap->in[17]; j.WT = (bf16_t*)(ws + WS_WDN); j.kscale = nullptr; j.K = DFF; j.N = DM; j.nrows = DM; j.kind = 0; j.kxor = 0; j.kscale_n = 0; ph_transpose(j, scr, gw, NGW, lane);
        j.qmax = ctl + CW_CMAX_G; j.W = ap->in[18]; j.WT = (bf16_t*)(ws + WS_WG); j.K = DM; ph_transpose_q8(j, scr, gw, NGW, lane); j.qmax = nullptr;
    }
    SEAM(3);
    if (IN(4)) { PH_IDS();
        for (int u = c; u < 1024; u += G) { const int ch = u >> 3, g = u & 7;
            ssd_stage<true>(lds, (const bf16_t*)(ws + WS_XBC), ap->in[6], ap->in[7], (const float*)(ws + WS_DT), ap->in[9], ch, g, tid, lane, wave);
            ssd_pass3_unit(lds, (const bf16_t*)(ws + WS_PREV), ap->in[10], (const bf16_t*)(ws + WS_Z), (bf16_t*)(ws + WS_MIX), ctl + CW_RSS_SSM, ch, g, tid, lane, wave); }
    }
    SEAM(4);
    if (IN(5)) { PH_IDS();
        pg8::Gemm g{(const bf16_t*)(ws + WS_MIX), (const bf16_t*)(ws + WS_WO), SEQ, DM, DM}; pg8::StaticOrder S; S.init(SEQ, DM, G, c);
        EpiWo E{32, ap->in[0], (bf16_t*)(ws + WS_XB), ctl + CW_RSS_SSM, ctl + CW_RSS1, (signed char*)(ws + WS_H1Q), (const float*)(ws + WS_RS0)};
        pg8::gemm_phase<EpiWo, pg8::StaticOrder, true, true>(lds, g, S, E);
    }
    SEAM(5);
    if (IN(6)) { PH_IDS();
        pg8::Gemm g{(const bf16_t*)(ws + WS_H1Q - 2 * DM), (const bf16_t*)(ws + WS_WUP), 65 * 256, 2 * DFF, DM, (size_t)254 * DM};     pg8::StaticOrder S; S.init(65 * 256, 2 * DFF, G, c);
        EpiUpConv E{0, (bf16_t*)(ws + WS_ACT), ctl + CW_RSS1, ap->in[15], ap->in[16], (LAS float*)(lds + RING_BYTES + 1024), (const float*)(ws + WS_RS0), ctl + CW_CMAX_UP};
        pg8::gemm_phase<EpiUpConv, pg8::StaticOrder, true, true>(lds, g, S, E);
    }
    SEAM(6);
    if (IN(7)) { PH_IDS();
        pg8::Gemm g{(const bf16_t*)(ws + WS_ACT), (const bf16_t*)(ws + WS_WDN), SEQ, DM, DFF}; pg8::StaticOrder S; S.init(SEQ, DM, G, c);
        EpiDown E{0, (bf16_t*)(ws + WS_XB), (signed char*)(ws + WS_H2Q), ctl + CW_RSS1};
        pg8::gemm_phase<EpiDown, pg8::StaticOrder, true, true>(lds, g, S, E);
    }
    SEAM(7);
    if (IN(8)) { PH_IDS();
        pg8::Gemm g{(const bf16_t*)(ws + WS_H2Q), (const bf16_t*)(ws + WS_WG), SEQ, DM, DM}; pg8::StaticOrder S; S.init(SEQ, DM, G, c);
        EpiGate E{0, ap->out, (const bf16_t*)(ws + WS_XB), (const bf16_t*)(ws + WS_PP), ap->in[19], ctl + CW_RSS3, ctl + CW_RSS1, ctl + CW_CMAX_G};
        pg8::gemm_phase<EpiGate, pg8::StaticOrder, true, true>(lds, g, S, E);
    }
    SEAM(8);
    if (IN(9)) { PH_IDS(); ph_final_norm(ap->out, ctl + CW_RSS3, ap->in[21], gt, NGT); }
#undef IN
#undef SEAM
}

#ifndef MK_N_LAUNCHES
#define MK_N_LAUNCHES 1
#endif
extern "C" void kernel_launch(void* const* d_in, const int* in_sizes, int n_in, void* d_out, int out_size, void* d_ws, size_t ws_size, hipStream_t stream) {
    if (n_in != 22 || out_size != SEQ * DM || ws_size < WS_END) { fprintf(stderr, "kernel_launch: unexpected shapes (n_in %d out %d ws %zu)\n", n_in, out_size, ws_size); return; }
    unsigned char* ws = (unsigned char*)d_ws;
    static int grid = 0;
    if (grid == 0) {
        int dev = 0, cus = 0, per_cu = 0;
        (void)hipGetDevice(&dev); (void)hipDeviceGetAttribute(&cus, hipDeviceAttributeMultiprocessorCount, dev);
        (void)hipFuncSetAttribute((const void*)k_fwd, hipFuncAttributeMaxDynamicSharedMemorySize, LDS_BYTES);
        (void)hipOccupancyMaxActiveBlocksPerMultiprocessor(&per_cu, (const void*)k_fwd, 512, LDS_BYTES);
        if (per_cu < 1) fprintf(stderr, "kernel_launch: occupancy query says %d blocks per CU\n", per_cu);
        (void)hipGetLastError();
        grid = cus > 0 ? cus : 256;
    }
    (void)hipMemsetAsync(ws + WS_CTL, 0, CTL_ZERO_BYTES, stream);
    Args a; memset(&a, 0, sizeof(a)); for (int i = 0; i < 22; ++i) a.in[i] = (const float*)d_in[i]; a.out = (float*)d_out; a.ws = ws;
    if (MK_N_LAUNCHES == 1) { a.ph_lo = 0; a.ph_hi = N_PHASES; a.li = 0; hipLaunchKernelGGL(k_fwd, dim3(grid), dim3(512), LDS_BYTES, stream, a); }
    else for (int k = 0; k < N_PHASES; ++k) { a.ph_lo = k; a.ph_hi = k + 1; a.li = k; hipLaunchKernelGGL(k_fwd, dim3(grid), dim3(512), LDS_BYTES, stream, a); }
}
```
